# Optimizing an MI355X kernel written in HIP

```python
import jax, jax.numpy as jnp
from jax import lax
import numpy as np

D_MODEL = 2048
BATCH = 1
SEQ = 16384
DEPTH = 1
DEC_BATCH = 2
DEC_SEQ = 16384
PAST_LEN = 128

HEAD_DIM = 128
DIL_GROUPS = ((128, 1), (512, 4), (2048, 16))
N_DIL_GROUPS = 3
DIL_HEADS = 4
DIL_QKV_WIDTH = N_DIL_GROUPS * DIL_HEADS * HEAD_DIM
DIL_OUT_WIDTH = DIL_HEADS * HEAD_DIM
BAND_BLOCK = 64
GQA_Q_HEADS = 12
GQA_KV_HEADS = 4
GQA_GROUP = GQA_Q_HEADS // GQA_KV_HEADS
GQA_Q_WIDTH = GQA_Q_HEADS * HEAD_DIM
GQA_KV_WIDTH = GQA_KV_HEADS * HEAD_DIM
GQA_OUT_WIDTH = GQA_Q_WIDTH
Q_BLOCK = 128
GRID_W = 64
ROPE_THETA = 10000.0
D_FF = 4 * D_MODEL
IN_SPLITS = (DIL_QKV_WIDTH, DIL_QKV_WIDTH, DIL_QKV_WIDTH,
             GQA_Q_WIDTH, GQA_KV_WIDTH, GQA_KV_WIDTH, D_MODEL, D_MODEL)
IN_WIDTH = sum(IN_SPLITS)
BRANCH_WIDTH = DIL_OUT_WIDTH + GQA_OUT_WIDTH
RMS_EPS = 1e-6
NEG_INF = -1e30

kernel_name = "hybrid_dilated_gqa_encoder"


def rms_norm(x, g):
    xf = x.astype(jnp.float32)
    y = xf * lax.rsqrt(jnp.mean(xf * xf, axis=-1, keepdims=True) + RMS_EPS)
    return (y * g.astype(jnp.float32)).astype(x.dtype)


def alibi_slopes():
    n = N_DIL_GROUPS * DIL_HEADS
    return 2.0 ** (-8.0 * jnp.arange(1, n + 1, dtype=jnp.float32) / n)


def dilated_band_attention(q, k, v, window, dilation, slopes):
    B, S, H, Dh = q.shape
    n_side = window // (2 * dilation)
    L = S // dilation
    nb = -(-L // BAND_BLOCK)
    Lp = nb * BAND_BLOCK

    def to_sub(a):
        return a.reshape(B, L, dilation, H, Dh).transpose(0, 2, 1, 3, 4)

    qs = jnp.pad(to_sub(q), ((0, 0), (0, 0), (0, Lp - L), (0, 0), (0, 0)))
    qs = qs.reshape(B, dilation, nb, BAND_BLOCK, H, Dh)

    def key_blocks(a):
        ap = jnp.pad(to_sub(a), ((0, 0), (0, 0), (BAND_BLOCK, Lp - L + BAND_BLOCK), (0, 0), (0, 0)))
        ap = ap.reshape(B, dilation, nb + 2, BAND_BLOCK, H, Dh)
        return jnp.concatenate([ap[:, :, :-2], ap[:, :, 1:-1], ap[:, :, 2:]], axis=3)

    kb = key_blocks(k)
    vb = key_blocks(v)
    s = jnp.einsum('brnqhd,brnkhd->brnhqk', qs, kb,
                   preferred_element_type=jnp.float32) * (HEAD_DIM ** -0.5)
    rel = (jnp.arange(3 * BAND_BLOCK)[None, :] - BAND_BLOCK
           - jnp.arange(BAND_BLOCK)[:, None])
    key_idx = (jnp.arange(nb)[:, None] * BAND_BLOCK - BAND_BLOCK
               + jnp.arange(3 * BAND_BLOCK)[None, :])
    mask = (jnp.abs(rel) <= n_side)[None] & ((key_idx >= 0) & (key_idx < L))[:, None, :]
    dist = (dilation * jnp.abs(rel)).astype(jnp.float32)
    s = s - slopes[:, None, None] * dist
    s = jnp.where(mask[:, None], s, NEG_INF)
    lse = jax.nn.logsumexp(s, axis=-1)
    p = jnp.exp(s - lse[..., None]).astype(v.dtype)
    o = jnp.einsum('brnhqk,brnkhd->brnqhd', p, vb)
    o = o.reshape(B, dilation, Lp, H, Dh)[:, :, :L].transpose(0, 2, 1, 3, 4).reshape(B, S, H, Dh)
    lse = lse.transpose(0, 1, 2, 4, 3).reshape(B, dilation, Lp, H)[:, :, :L]
    lse = lse.transpose(0, 2, 1, 3).reshape(B, S, H)
    return o, lse


def dilated_mixer(q, k, v):
    B, S, _ = q.shape
    shp = (B, S, N_DIL_GROUPS, DIL_HEADS, HEAD_DIM)
    q, k, v = q.reshape(shp), k.reshape(shp), v.reshape(shp)
    slopes = alibi_slopes().reshape(N_DIL_GROUPS, DIL_HEADS)
    outs, lses = [], []
    for g, (w, d) in enumerate(DIL_GROUPS):
        o, l = dilated_band_attention(q[:, :, g], k[:, :, g], v[:, :, g], w, d, slopes[g])
        outs.append(o)
        lses.append(l)
    wts = jax.nn.softmax(jnp.stack(lses, axis=0), axis=0)
    y = sum(wts[g][..., None] * outs[g].astype(jnp.float32) for g in range(N_DIL_GROUPS))
    return y.reshape(B, S, DIL_OUT_WIDTH).astype(q.dtype)


def axial_rope_tables(S):
    rows = S // GRID_W
    row = jnp.broadcast_to(jnp.arange(rows)[:, None], (rows, GRID_W)).reshape(S).astype(jnp.float32)
    col = jnp.broadcast_to(jnp.arange(GRID_W)[None, :], (rows, GRID_W)).reshape(S).astype(jnp.float32)
    half = HEAD_DIM // 2
    inv_freq = ROPE_THETA ** (-jnp.arange(0, half, 2, dtype=jnp.float32) / half)
    ang = jnp.stack([row[:, None] * inv_freq, col[:, None] * inv_freq], axis=1)
    return jnp.cos(ang), jnp.sin(ang)


def apply_axial_rope(x, cos, sin):
    B, S, H, _ = x.shape
    xf = x.astype(jnp.float32).reshape(B, S, H, 2, 2, HEAD_DIM // 4)
    x1, x2 = xf[..., 0, :], xf[..., 1, :]
    c = cos[None, :, None]
    s = sin[None, :, None]
    out = jnp.stack([x1 * c - x2 * s, x2 * c + x1 * s], axis=-2)
    return out.reshape(B, S, H, HEAD_DIM).astype(x.dtype)


def gqa_mixer(q, k, v, g_q, g_k):
    B, S, _ = q.shape
    q = rms_norm(q.reshape(B, S, GQA_Q_HEADS, HEAD_DIM), g_q)
    k = rms_norm(k.reshape(B, S, GQA_KV_HEADS, HEAD_DIM), g_k)
    v = v.reshape(B, S, GQA_KV_HEADS, HEAD_DIM)
    cos, sin = axial_rope_tables(S)
    q = apply_axial_rope(q, cos, sin)
    k = apply_axial_rope(k, cos, sin)
    nq = S // Q_BLOCK
    qb = q.reshape(B, nq, Q_BLOCK, GQA_KV_HEADS, GQA_GROUP, HEAD_DIM).transpose(1, 0, 2, 3, 4, 5)
    scale = HEAD_DIM ** -0.5

    def attend(qblk):
        s = jnp.einsum('bqhgd,bkhd->bhgqk', qblk, k, preferred_element_type=jnp.float32) * scale
        p = jax.nn.softmax(s, axis=-1).astype(v.dtype)
        return jnp.einsum('bhgqk,bkhd->bqhgd', p, v)

    o = lax.map(attend, qb)
    return o.transpose(1, 0, 2, 3, 4, 5).reshape(B, S, GQA_OUT_WIDTH)


def encoder_layer(x, g_mix, w_in, g_q, g_k, w_branch, w_out, g_mlp, w_ff1, w_ff2):
    h = rms_norm(x, g_mix)
    proj = h @ w_in
    idx = np.cumsum(IN_SPLITS)[:-1].tolist()
    aq, ak, av, bq, bk, bv, ga, gb = jnp.split(proj, idx, axis=-1)
    y_a = dilated_mixer(aq, ak, av)
    y_b = gqa_mixer(bq, bk, bv, g_q, g_k)
    o_a = y_a @ w_branch[:DIL_OUT_WIDTH]
    o_b = y_b @ w_branch[DIL_OUT_WIDTH:]
    merged = jax.nn.sigmoid(ga) * o_a + jax.nn.sigmoid(gb) * o_b
    x = x + merged @ w_out
    h2 = rms_norm(x, g_mlp)
    u = jax.nn.relu(h2 @ w_ff1)
    return x + (u * u) @ w_ff2


def trunk(x, g_mix, w_in, g_q, g_k, w_branch, w_out, g_mlp, w_ff1, w_ff2, g_final):
    for l in range(DEPTH):
        x = encoder_layer(x, g_mix[l], w_in[l], g_q[l], g_k[l], w_branch[l], w_out[l],
                          g_mlp[l], w_ff1[l], w_ff2[l])
    return rms_norm(x, g_final)


def setup_inputs(seed: int = 0) -> dict:
    key = jax.random.key(seed)
    ks = jax.random.split(key, 13)
    f32 = jnp.float32
    nrm = lambda k, shp: jax.random.normal(k, shp, f32)
    branch_scale = jnp.concatenate([jnp.full((DIL_OUT_WIDTH,), DIL_OUT_WIDTH ** -0.5, f32),
                                    jnp.full((GQA_OUT_WIDTH,), GQA_OUT_WIDTH ** -0.5, f32)])[:, None]
    return {
        "x_prompt": nrm(ks[0], (BATCH, SEQ, D_MODEL)),
        "x_sample": nrm(ks[1], (DEC_BATCH, DEC_SEQ, D_MODEL)),
        "g_mix": 1.0 + 0.02 * nrm(ks[2], (DEPTH, D_MODEL)),
        "w_in": nrm(ks[3], (DEPTH, D_MODEL, IN_WIDTH)) * D_MODEL ** -0.5,
        "g_q": 1.0 + 0.02 * nrm(ks[4], (DEPTH, HEAD_DIM)),
        "g_k": 1.0 + 0.02 * nrm(ks[5], (DEPTH, HEAD_DIM)),
        "w_branch": nrm(ks[6], (DEPTH, BRANCH_WIDTH, D_MODEL)) * branch_scale,
        "w_out": nrm(ks[7], (DEPTH, D_MODEL, D_MODEL)) * D_MODEL ** -0.5,
        "g_mlp": 1.0 + 0.02 * nrm(ks[8], (DEPTH, D_MODEL)),
        "w_ff1": nrm(ks[9], (DEPTH, D_MODEL, D_FF)) * D_MODEL ** -0.5,
        "w_ff2": nrm(ks[10], (DEPTH, D_FF, D_MODEL)) * D_FF ** -0.5,
        "g_final": 1.0 + 0.02 * nrm(ks[11], (D_MODEL,)),
    }


def reference(x_prompt, x_sample, g_mix, w_in, g_q, g_k, w_branch, w_out, g_mlp, w_ff1, w_ff2, g_final):
    y_prompt = trunk(x_prompt, g_mix, w_in, g_q, g_k, w_branch, w_out, g_mlp, w_ff1, w_ff2, g_final)
    y_sample = trunk(x_sample, g_mix, w_in, g_q, g_k, w_branch, w_out, g_mlp, w_ff1, w_ff2, g_final)
    return (y_prompt, y_sample)
```

```cpp
#include <hip/hip_runtime.h>
#include <cstdio>
#include <cstdint>

#ifndef MK_N_LAUNCHES
#define MK_N_LAUNCHES 26
#endif

namespace pg8 {
#define PG8_LAS __attribute__((address_space(3)))
typedef unsigned short bf16_t;
typedef short bf16x8 __attribute__((ext_vector_type(8)));
typedef float f32x4 __attribute__((ext_vector_type(4)));
typedef unsigned u32x4 __attribute__((ext_vector_type(4)));
constexpr int BM = 256, BK = 64, HALF = 128, HTB = HALF * BK * 2  , STAGE_BYTES = 8 * HTB, NXCD = 8, WGM = 8;

__host__ __device__ __forceinline__ int lds_byte(int r, int c) { const int st = (r >> 4) * 2 + (c >> 5), rr = r & 15, cc = c & 31, ob = rr * 64 + cc * 2; return st * 1024 + (ob ^ (((ob >> 9) & 1) << 5)); }
__host__ __device__ __forceinline__ void stage_rc(int b, int& R, int& C) { const int st = b / 1024, sb = b % 1024, swz = sb ^ (((sb >> 9) & 1) << 5); R = (st >> 1) * 16 + swz / 64; C = (st & 1) * 32 + (swz % 64) / 2; }
__host__ __device__ __forceinline__ int perm32(int rho) { const int n = rho >> 4, i = rho & 15; return 8 * (i >> 2) + 4 * n + (i & 3); }

struct Unit { int pm, pn; };
struct Gemm { const bf16_t* A; const bf16_t* Bt; int M, N, K; };

struct StaticOrder {
    int nM, nN, nwg, G, c;
    __host__ __device__ void init(int M, int N, int G_, int c_) { nM = M / BM; nN = N / BM; nwg = nM * nN; G = G_; c = c_; }
    __host__ __device__ bool next(int i, Unit& u) const {
        const long L = (long)i * G + c; if (L >= nwg) return false;
        int wgid = (int)L; { const int q = nwg / NXCD, r = nwg % NXCD, xcd = wgid % NXCD, off = wgid / NXCD; wgid = (xcd < r ? xcd * (q + 1) : r * (q + 1) + (xcd - r) * q) + off; }
        const int nig = WGM * nN, gid = wgid / nig, fm = gid * WGM, gsz = (nM - fm) < WGM ? (nM - fm) : WGM;
        u.pm = fm + ((wgid % nig) % gsz); u.pn = (wgid % nig) / gsz; return true;
    }
    __device__ __forceinline__ void a_ready(const Unit&) const {}
    __device__ __forceinline__ void done(const Unit&) const {}
};


__device__ __forceinline__ int otid() { int t = threadIdx.x; asm volatile("" : "+v"(t)); return t; }
__device__ __forceinline__ unsigned cvt_pk_bf16(float lo, float hi) { unsigned r; asm volatile("v_cvt_pk_bf16_f32 %0, %1, %2" : "=v"(r) : "v"(lo), "v"(hi)); return r; }
__device__ __forceinline__ float bf_lo(unsigned w) { return __uint_as_float(w << 16); }
__device__ __forceinline__ float bf_hi(unsigned w) { return __uint_as_float(w & 0xffff0000u); }

template <int ACT> struct EpiBf16 {
    static constexpr bool PERM = true, AFTER_DRAIN = false, HAS_MID = false; static constexpr int MID_T = -1;
    bf16_t* O; int ldc;
    __device__ __forceinline__ void mid(f32x4 (&)[2][2][4][2], const Unit&, int, int, int, int) const {}
    __device__ __forceinline__ void operator()(const f32x4 (&acc)[2][2][4][2], const Unit& u, int wr, int wc, int fr, int fq) const {
        const int row0 = u.pm * BM + wr * 64 + fr; const int col0 = u.pn * BM + wc * 32 + 8 * fq;
#pragma unroll
        for (int ai = 0; ai < 2; ++ai)
#pragma unroll
            for (int m = 0; m < 4; ++m) { bf16_t* rowp = O + (size_t)(row0 + ai * HALF + m * 16) * ldc + col0;
#pragma unroll
                for (int bj = 0; bj < 2; ++bj) { f32x4 v0 = acc[ai][bj][m][0], v1 = acc[ai][bj][m][1];
                    if (ACT == 2) {
#pragma unroll
                        for (int e = 0; e < 4; ++e) { float a = fmaxf(v0[e], 0.f), b = fmaxf(v1[e], 0.f); v0[e] = a * a; v1[e] = b * b; } }
                    u32x4 w; w.x = cvt_pk_bf16(v0[0], v0[1]); w.y = cvt_pk_bf16(v0[2], v0[3]); w.z = cvt_pk_bf16(v1[0], v1[1]); w.w = cvt_pk_bf16(v1[2], v1[3]);
                    *(u32x4*)(rowp + bj * HALF) = w; } }
    }
};
struct EpiGate {
    static constexpr bool PERM = true, AFTER_DRAIN = false, HAS_MID = true; static constexpr int MID_T = 8;
    bf16_t* O; int ldc; const bf16_t* G; int ldg, ga0, gb0; unsigned gbytes;
    __device__ __forceinline__ void mid(f32x4 (&acc)[2][2][4][2], const Unit& u, int wr, int wc, int fr, int fq) const {
        const __amdgpu_buffer_rsrc_t rs = __builtin_amdgcn_make_buffer_rsrc((void*)G, 0, gbytes, 0x00020000);
        const int voff = ((wr * 64 + fr) * ldg + wc * 32 + 8 * fq) * 2;
        const int sb = (u.pm * BM * ldg + u.pn * BM) * 2;
#pragma unroll
        for (int ai = 0; ai < 2; ++ai)
#pragma unroll
            for (int m = 0; m < 4; ++m) { const int so = sb + (ai * HALF + m * 16) * ldg * 2;
#pragma unroll
                for (int bj = 0; bj < 2; ++bj) { const u32x4 a = __builtin_amdgcn_raw_buffer_load_b128(rs, voff, so + (ga0 + bj * HALF) * 2, 0), b = __builtin_amdgcn_raw_buffer_load_b128(rs, voff, so + (gb0 + bj * HALF) * 2, 0);
#pragma unroll
                    for (int e = 0; e < 4; ++e) { const float al = bf_lo(a[e]), ah = bf_hi(a[e]), bl = bf_lo(b[e]), bh = bf_hi(b[e]);
                        const float rl = (1.f + __expf(-bl)) * __builtin_amdgcn_rcpf(1.f + __expf(-al)), rh = (1.f + __expf(-bh)) * __builtin_amdgcn_rcpf(1.f + __expf(-ah));
                        acc[ai][bj][m][e >> 1][(e & 1) * 2 + 0] *= rl; acc[ai][bj][m][e >> 1][(e & 1) * 2 + 1] *= rh; } }
                if (m & 1) asm volatile("" ::: "memory"); }
    }
    __device__ __forceinline__ void operator()(const f32x4 (&acc)[2][2][4][2], const Unit& u, int wr, int wc, int fr, int fq) const {
        const __amdgpu_buffer_rsrc_t rs = __builtin_amdgcn_make_buffer_rsrc((void*)G, 0, gbytes, 0x00020000);
        const int voff = ((wr * 64 + fr) * ldg + wc * 32 + 8 * fq) * 2;
        const int sb = (u.pm * BM * ldg + u.pn * BM) * 2;
        const int row0 = u.pm * BM + wr * 64 + fr; const int col0 = u.pn * BM + wc * 32 + 8 * fq;
#pragma unroll
        for (int ai = 0; ai < 2; ++ai)
#pragma unroll
            for (int m = 0; m < 4; ++m) { const size_t r = (size_t)(row0 + ai * HALF + m * 16); bf16_t* rowp = O + r * ldc + col0; const int so = sb + (ai * HALF + m * 16) * ldg * 2;
#pragma unroll
                for (int bj = 0; bj < 2; ++bj) { const u32x4 b = __builtin_amdgcn_raw_buffer_load_b128(rs, voff, so + (gb0 + bj * HALF) * 2, 0); float v[8];
#pragma unroll
                    for (int e = 0; e < 4; ++e) { const float bl = bf_lo(b[e]), bh = bf_hi(b[e]);
                        v[2 * e] = acc[ai][bj][m][e >> 1][(e & 1) * 2 + 0] * __builtin_amdgcn_rcpf(1.f + __expf(-bl));
                        v[2 * e + 1] = acc[ai][bj][m][e >> 1][(e & 1) * 2 + 1] * __builtin_amdgcn_rcpf(1.f + __expf(-bh)); }
                    u32x4 w; w.x = cvt_pk_bf16(v[0], v[1]); w.y = cvt_pk_bf16(v[2], v[3]); w.z = cvt_pk_bf16(v[4], v[5]); w.w = cvt_pk_bf16(v[6], v[7]);
                    *(u32x4*)(rowp + bj * HALF) = w; }
                if (m & 1) asm volatile("" ::: "memory"); }
    }
};
struct EpiResF32 {
    static constexpr bool PERM = false, AFTER_DRAIN = false, HAS_MID = false; static constexpr int MID_T = -1;
    const float* base; float* out; int ldc;
    __device__ __forceinline__ void mid(f32x4 (&)[2][2][4][2], const Unit&, int, int, int, int) const {}
    __device__ __forceinline__ void operator()(const f32x4 (&acc)[2][2][4][2], const Unit& u, int wr, int wc, int fr, int fq) const {
        const int row0 = u.pm * BM + wr * 64 + fr; const int col0 = u.pn * BM + wc * 32 + 4 * fq;
#pragma unroll
        for (int ai = 0; ai < 2; ++ai)
#pragma unroll
            for (int m = 0; m < 4; ++m) { const size_t off = (size_t)(row0 + ai * HALF + m * 16) * ldc + col0;
#pragma unroll
                for (int bj = 0; bj < 2; ++bj)
#pragma unroll
                    for (int n = 0; n < 2; ++n) { const f32x4 bs = *(const f32x4*)(base + off + bj * HALF + n * 16); *(f32x4*)(out + off + bj * HALF + n * 16) = bs + acc[ai][bj][m][n]; }
                if (m & 1) asm volatile("" ::: "memory"); }
    }
};

template <class Epi, class Sched, bool ALIGN_EPI = false, bool SP2 = false>
__device__ __forceinline__ void gemm_phase(PG8_LAS unsigned char* lds, const Gemm g, const Sched& S, const Epi& E) {
    const int tid = otid(), wid = __builtin_amdgcn_readfirstlane(tid >> 6), lane = tid & 63, wr = wid >> 2, wc = wid & 3, fr = lane & 15, fq = lane >> 4;
    const int K = g.K, nt = K / BK;
    unsigned voffA[2], voffB[2];
#pragma unroll
    for (int i = 0; i < 2; ++i) { int R, C; stage_rc(tid * 16 + i * 8192, R, C); const int Rb = Epi::PERM ? ((R & ~31) + perm32(R & 31)) : R;
        voffA[i] = (unsigned)(R * K + C) * 2u; voffB[i] = (unsigned)(Rb * K + C) * 2u; }
    const size_t kstep = (size_t)(BK * 2);
    const size_t hstep = (size_t)HALF * K * 2;
    const size_t tstep = 2 * hstep;
    const unsigned ldsw = (unsigned)wid * 1024u;
    const int aoff = lds_byte(wr * 64 + fr, fq * 8), boff = lds_byte(wc * 32 + fr, fq * 8);
#define PG8_SA(b, h) (((b) * 2 + (h)) * HTB)
#define PG8_SB(b, h) ((4 + (b) * 2 + (h)) * HTB)
#define PG8_STAGE(bufoff, gbase, voff) do { _Pragma("unroll") for (int _i = 0; _i < 2; ++_i) \
        __builtin_amdgcn_global_load_lds((const unsigned*)((const char*)(gbase) + (voff)[_i]), (PG8_LAS unsigned*)(lds + (bufoff) + ldsw + _i * 8192), 16, 0, 0); } while (0)
#define PG8_LDA(dst, b, h) do { _Pragma("unroll") for (int m = 0; m < 4; ++m) _Pragma("unroll") for (int k = 0; k < 2; ++k) dst[m][k] = *(const PG8_LAS bf16x8*)(lds + PG8_SA(b, h) + aoff + m * 2048 + k * 1024); } while (0)
#define PG8_LDB(dst, b, h) do { _Pragma("unroll") for (int n = 0; n < 2; ++n) _Pragma("unroll") for (int k = 0; k < 2; ++k) dst[n][k] = *(const PG8_LAS bf16x8*)(lds + PG8_SB(b, h) + boff + n * 2048 + k * 1024); } while (0)
#define PG8_MMA(ai, bj, At, Bt) do { __builtin_amdgcn_s_setprio(1); _Pragma("unroll") for (int m = 0; m < 4; ++m) _Pragma("unroll") for (int n = 0; n < 2; ++n) _Pragma("unroll") for (int k = 0; k < 2; ++k) \
        acc[ai][bj][m][n] = __builtin_amdgcn_mfma_f32_16x16x32_bf16(Bt[n][k], At[m][k], acc[ai][bj][m][n], 0, 0, 0); __builtin_amdgcn_s_setprio(0); } while (0)
#define PG8_WAIT_V(n) asm volatile("s_waitcnt vmcnt(" #n ")" ::: "memory")
#define PG8_WAIT_L(n) asm volatile("s_waitcnt lgkmcnt(" #n ")" ::: "memory")
#define PG8_BAR __builtin_amdgcn_s_barrier()
#define PG8_SCHED __builtin_amdgcn_sched_barrier(0)
    Unit cur, nxt; int ui = 0;
    if (!S.next(0, cur)) return;
    f32x4 acc[2][2][4][2];
#pragma unroll
    for (int a = 0; a < 2; ++a)
#pragma unroll
        for (int b = 0; b < 2; ++b)
#pragma unroll
            for (int m = 0; m < 4; ++m)
#pragma unroll
                for (int n = 0; n < 2; ++n) acc[a][b][m][n] = (f32x4){0.f, 0.f, 0.f, 0.f};
    bf16x8 At[4][2], B0[2][2], B1[2][2];
    const char* cA = (const char*)g.A + (size_t)cur.pm * tstep; const char* cB = (const char*)g.Bt + (size_t)cur.pn * tstep;
    S.a_ready(cur);
    if constexpr (SP2) {
        PG8_STAGE(PG8_SB(0, 0), cB, voffB); PG8_STAGE(PG8_SB(0, 1), cB + hstep, voffB); PG8_STAGE(PG8_SA(0, 0), cA, voffA); PG8_STAGE(PG8_SA(0, 1), cA + hstep, voffA);
        if (wr == 1) PG8_BAR;
        PG8_WAIT_V(2); PG8_BAR;
        PG8_STAGE(PG8_SB(1, 0), cB + kstep, voffB); PG8_STAGE(PG8_SA(1, 0), cA + kstep, voffA); PG8_STAGE(PG8_SB(1, 1), cB + hstep + kstep, voffB);
        PG8_WAIT_V(6); PG8_BAR;
    } else {
        PG8_STAGE(PG8_SB(0, 0), cB, voffB); PG8_STAGE(PG8_SA(0, 0), cA, voffA); PG8_STAGE(PG8_SB(0, 1), cB + hstep, voffB); PG8_STAGE(PG8_SA(0, 1), cA + hstep, voffA);
        if (wr == 1) PG8_BAR;
        PG8_WAIT_V(4); PG8_BAR;
        PG8_STAGE(PG8_SB(1, 0), cB + kstep, voffB); PG8_STAGE(PG8_SA(1, 0), cA + kstep, voffA); PG8_STAGE(PG8_SB(1, 1), cB + hstep + kstep, voffB);
        PG8_WAIT_V(6); PG8_BAR;
    }
    for (;;) {
        const bool has_next = S.next(ui + 1, nxt);
        const char* nA = has_next ? (const char*)g.A + (size_t)nxt.pm * tstep : cA; const char* nB = has_next ? (const char*)g.Bt + (size_t)nxt.pn * tstep : cB;
        for (int t = 0; t < nt; t += 2) {
            const bool last = (t == nt - 2);
            const char* a1 = cA + (size_t)(t + 1) * kstep;
            const char* a2 = last ? nA : cA + (size_t)(t + 2) * kstep; const char* b2 = last ? nB : cB + (size_t)(t + 2) * kstep;
            const char* a3 = a2 + kstep; const char* b3 = b2 + kstep;
            if (last && has_next) S.a_ready(nxt);
            if constexpr (Epi::HAS_MID) { if (t == Epi::MID_T) { E.mid(acc, cur, wr, wc, fr, fq); PG8_WAIT_V(0); } }
            if constexpr (SP2) {
            PG8_LDB(B0, 0, 0); PG8_LDB(B1, 0, 1); PG8_SCHED; PG8_LDA(At, 0, 0); PG8_STAGE(PG8_SA(1, 1), a1 + hstep, voffA);
            PG8_WAIT_V(8); PG8_WAIT_L(0); PG8_BAR; PG8_MMA(0, 0, At, B0); PG8_MMA(0, 1, At, B1); PG8_BAR; PG8_SCHED;
            PG8_LDA(At, 0, 1); PG8_STAGE(PG8_SB(0, 0), b2, voffB); PG8_STAGE(PG8_SB(0, 1), b2 + hstep, voffB); PG8_STAGE(PG8_SA(0, 0), a2, voffA);
            PG8_WAIT_V(8); PG8_WAIT_L(0); PG8_BAR; PG8_MMA(1, 0, At, B0); PG8_MMA(1, 1, At, B1); PG8_BAR; PG8_SCHED;
            PG8_LDB(B0, 1, 0); PG8_LDB(B1, 1, 1); PG8_SCHED; PG8_LDA(At, 1, 0); PG8_STAGE(PG8_SA(0, 1), a2 + hstep, voffA);
            PG8_WAIT_V(8); PG8_WAIT_L(0); PG8_BAR; PG8_MMA(0, 0, At, B0); PG8_MMA(0, 1, At, B1); PG8_BAR; PG8_SCHED;
            PG8_LDA(At, 1, 1); PG8_STAGE(PG8_SB(1, 0), b3, voffB); PG8_STAGE(PG8_SB(1, 1), b3 + hstep, voffB); PG8_STAGE(PG8_SA(1, 0), a3, voffA);
            PG8_WAIT_V(8); PG8_WAIT_L(0); PG8_BAR; PG8_MMA(1, 0, At, B0); PG8_MMA(1, 1, At, B1); PG8_BAR; PG8_SCHED;
            } else {
            PG8_LDB(B0, 0, 0); PG8_SCHED; PG8_LDA(At, 0, 0); PG8_STAGE(PG8_SA(1, 1), a1 + hstep, voffA);
            PG8_WAIT_L(8); PG8_BAR; PG8_WAIT_L(0); PG8_MMA(0, 0, At, B0); PG8_BAR; PG8_SCHED;
            PG8_LDB(B1, 0, 1); PG8_STAGE(PG8_SB(0, 0), b2, voffB);
            PG8_BAR; PG8_WAIT_L(0); PG8_MMA(0, 1, At, B1); PG8_BAR;
            PG8_LDA(At, 0, 1); PG8_STAGE(PG8_SA(0, 0), a2, voffA);
            PG8_BAR; PG8_WAIT_L(0); PG8_MMA(1, 0, At, B0); PG8_BAR; PG8_SCHED;
            PG8_STAGE(PG8_SB(0, 1), b2 + hstep, voffB);
            PG8_WAIT_V(6); PG8_BAR; PG8_MMA(1, 1, At, B1); PG8_BAR;
            PG8_LDB(B0, 1, 0); PG8_SCHED; PG8_LDA(At, 1, 0); PG8_STAGE(PG8_SA(0, 1), a2 + hstep, voffA);
            PG8_WAIT_L(8); PG8_BAR; PG8_WAIT_L(0); PG8_MMA(0, 0, At, B0); PG8_BAR; PG8_SCHED;
            PG8_LDB(B1, 1, 1); PG8_STAGE(PG8_SB(1, 0), b3, voffB);
            PG8_BAR; PG8_WAIT_L(0); PG8_MMA(0, 1, At, B1); PG8_BAR;
            PG8_LDA(At, 1, 1); PG8_STAGE(PG8_SA(1, 0), a3, voffA);
            PG8_BAR; PG8_WAIT_L(0); PG8_MMA(1, 0, At, B0); PG8_BAR; PG8_SCHED;
            PG8_STAGE(PG8_SB(1, 1), b3 + hstep, voffB);
            PG8_WAIT_V(6); PG8_BAR; PG8_MMA(1, 1, At, B1); PG8_BAR;
            }
        }
        if constexpr (ALIGN_EPI) { if (wr == 0) PG8_BAR; }
        if constexpr (!Epi::AFTER_DRAIN) { E(acc, cur, wr, wc, fr, fq); S.done(cur); }
        if (!has_next) break;
#pragma unroll
        for (int a = 0; a < 2; ++a)
#pragma unroll
            for (int b = 0; b < 2; ++b)
#pragma unroll
                for (int m = 0; m < 4; ++m)
#pragma unroll
                    for (int n = 0; n < 2; ++n) acc[a][b][m][n] = (f32x4){0.f, 0.f, 0.f, 0.f};
        cur = nxt; cA = nA; cB = nB; ++ui;
        if constexpr (ALIGN_EPI) { if (wr == 1) PG8_BAR; }
    }
    PG8_WAIT_V(0);
    if constexpr (!ALIGN_EPI) { if (wr == 0) PG8_BAR; }
    PG8_BAR;
    if constexpr (Epi::AFTER_DRAIN) { E.fused(acc, cur, wr, wc, fr, fq, lds, wid, lane); S.done(cur); }
#undef PG8_SA
#undef PG8_SB
#undef PG8_STAGE
#undef PG8_LDA
#undef PG8_LDB
#undef PG8_MMA
#undef PG8_WAIT_V
#undef PG8_WAIT_L
#undef PG8_BAR
#undef PG8_SCHED
}
}


constexpr int DM = 2048, SEQ = 16384, NSEQ = 3, HD = 128, DFF = 8192, INW = 11264;
constexpr int C_AQ = 0, C_AK = 1536, C_AV = 3072, C_BQ = 4608, C_BK = 6144, C_BV = 6656, C_GA = 7168, C_GB = 9216;
constexpr float RMS_EPS = 1e-6f;
constexpr float LOG2E = 1.4426950408889634f, LN2 = 0.6931471805599453f;

namespace att {
typedef unsigned short bf16;
constexpr int D = 128, NW = 8, QBLK = 32, KVBLK = 64;
constexpr float SCALE = 0.088388347648318440f;
constexpr float THR = 8.f;
constexpr int SHM_V = KVBLK * D * 2, SHM_K = KVBLK * D * 2, SHM_ATTN = 2 * SHM_V + 2 * SHM_K + NW * 64 * 4;
using bf16x8 = __attribute__((ext_vector_type(8))) short;
using s16x4  = __attribute__((ext_vector_type(4))) short;
using f32x16 = __attribute__((ext_vector_type(16))) float;
using u32x4  = __attribute__((ext_vector_type(4))) unsigned;
#define KSWZ(row, colB) ((row) * 256 + ((colB) ^ (((row) & 7) << 4)))
#define SBAR() __builtin_amdgcn_sched_barrier(0)
__device__ __forceinline__ int crow(int r, int hi) { return (r & 3) + 8 * (r >> 2) + 4 * hi; }
__device__ __forceinline__ unsigned cvtpk(float lo, float hi) { unsigned r; asm volatile("v_cvt_pk_bf16_f32 %0, %1, %2" : "=v"(r) : "v"(lo), "v"(hi)); return r; }
__device__ __forceinline__ bf16x8 ld8(const bf16* p) { return *reinterpret_cast<const bf16x8*>(p); }

__device__ __forceinline__ void partialSM(f32x16& p0, f32x16& p1, float& m_reg, float& mn, float& alpha) {
  constexpr float C = SCALE * 1.4426950408889634f;
  float pmax = p0[0]; for (int r = 1; r < 16; ++r) pmax = fmaxf(pmax, p0[r]); for (int r = 0; r < 16; ++r) pmax = fmaxf(pmax, p1[r]);
  { auto rr = __builtin_amdgcn_permlane32_swap(__float_as_uint(pmax), __float_as_uint(pmax), false, false);
    pmax = fmaxf(__uint_as_float(rr[0]), __uint_as_float(rr[1])); }
  if (__builtin_expect(__all(pmax - m_reg <= THR / SCALE), 1)) { mn = m_reg; alpha = 1.f; }
  else { mn = fmaxf(m_reg, pmax); alpha = __builtin_amdgcn_exp2f((m_reg - mn) * C); m_reg = mn; }
  float mnC = -mn * C;
  for (int r = 0; r < 16; ++r) p0[r] = fmaf(p0[r], C, mnC); for (int r = 0; r < 16; ++r) p1[r] = fmaf(p1[r], C, mnC);
  for (int r = 0; r < 16; ++r) p0[r] = __builtin_amdgcn_exp2f(p0[r]);
}
#define PK4(P, BASE, OUT) do { unsigned a0 = cvtpk(P[BASE + 0], P[BASE + 1]), a1 = cvtpk(P[BASE + 2], P[BASE + 3]);   \
    unsigned b0 = cvtpk(P[BASE + 4], P[BASE + 5]), b1 = cvtpk(P[BASE + 6], P[BASE + 7]);                              \
    auto r0 = __builtin_amdgcn_permlane32_swap(a0, b0, false, false); auto r1 = __builtin_amdgcn_permlane32_swap(a1, b1, false, false); \
    u32x4 w = {r0[0], r1[0], r0[1], r1[1]}; OUT = *reinterpret_cast<bf16x8*>(&w); } while (0)
__device__ __forceinline__ void finishSM(f32x16& p0, f32x16& p1, float alpha, float& l_reg, bf16x8& pa0, bf16x8& pa1, bf16x8& pa2, bf16x8& pa3) {
  for (int r = 0; r < 16; ++r) p1[r] = __builtin_amdgcn_exp2f(p1[r]);
  float ps = 0; for (int r = 0; r < 16; ++r) ps += p0[r]; for (int r = 0; r < 16; ++r) ps += p1[r];
  { auto rr = __builtin_amdgcn_permlane32_swap(__float_as_uint(ps), __float_as_uint(ps), false, false);
    ps = __uint_as_float(rr[0]) + __uint_as_float(rr[1]); }
  l_reg = l_reg * alpha + ps;
  PK4(p0, 0, pa0); PK4(p0, 8, pa1); PK4(p1, 0, pa2); PK4(p1, 8, pa3);
}
__device__ __forceinline__ void qkt(f32x16& p0, f32x16& p1, const bf16* Ks, const bf16x8* qr, int r32, int hi) {
  p0 = f32x16{}; p1 = f32x16{};
  for (int d0 = 0; d0 < 8; ++d0) { int cb = (d0 * 16 + hi * 8) * 2;
    bf16x8 b0 = *reinterpret_cast<const bf16x8*>((const char*)Ks + KSWZ(r32, cb));
    bf16x8 b1 = *reinterpret_cast<const bf16x8*>((const char*)Ks + KSWZ(32 + r32, cb));
    p0 = __builtin_amdgcn_mfma_f32_32x32x16_bf16(b0, qr[d0], p0, 0, 0, 0);
    p1 = __builtin_amdgcn_mfma_f32_32x32x16_bf16(b1, qr[d0], p1, 0, 0, 0); }
}
__device__ __forceinline__ int v_st(int k, int c) { const int kk = (k & ~0xC) | ((k & 4) << 1) | ((k & 8) >> 1); return ((kk >> 3) * 4 + (c >> 5)) * 512 + ((kk & 7) * 32 + (c & 31)) * 2; }
__device__ __forceinline__ int v_rd_base(int lane) { return ((lane & 3) << 3) | (((lane >> 2) & 3) << 6) | (((lane >> 4) & 1) << 5) | (((lane >> 5) & 1) << 8); }
constexpr int v_rd_off(int d0, int ks, int half) { return d0 * 512 + ks * 4096 + half * 2048; }
template <int OFF> __device__ __forceinline__ s16x4 tr_read(int vb) {
  s16x4 r; asm volatile("ds_read_b64_tr_b16 %0, %1 offset:%2" : "=&v"(r) : "v"(vb), "i"(OFF) : "memory"); return r;
}
template <int D0> __device__ __forceinline__ void pv_one(f32x16& od, int vb, bf16x8 pa0, bf16x8 pa1, bf16x8 pa2, bf16x8 pa3) {
  const s16x4 l0 = tr_read<v_rd_off(D0, 0, 0)>(vb), h0 = tr_read<v_rd_off(D0, 0, 1)>(vb), l1 = tr_read<v_rd_off(D0, 1, 0)>(vb), h1 = tr_read<v_rd_off(D0, 1, 1)>(vb);
  const s16x4 l2 = tr_read<v_rd_off(D0, 2, 0)>(vb), h2 = tr_read<v_rd_off(D0, 2, 1)>(vb), l3 = tr_read<v_rd_off(D0, 3, 0)>(vb), h3 = tr_read<v_rd_off(D0, 3, 1)>(vb);
  asm volatile("s_waitcnt lgkmcnt(0)" ::: "memory"); SBAR();
#define PK(L, H) (bf16x8){L[0], L[1], L[2], L[3], H[0], H[1], H[2], H[3]}
  od = __builtin_amdgcn_mfma_f32_32x32x16_bf16(pa0, PK(l0, h0), od, 0, 0, 0);
  od = __builtin_amdgcn_mfma_f32_32x32x16_bf16(pa1, PK(l1, h1), od, 0, 0, 0);
  od = __builtin_amdgcn_mfma_f32_32x32x16_bf16(pa2, PK(l2, h2), od, 0, 0, 0);
  od = __builtin_amdgcn_mfma_f32_32x32x16_bf16(pa3, PK(l3, h3), od, 0, 0, 0);
#undef PK
}
__device__ __forceinline__ void pv_d0(f32x16* o, int vb, bf16x8 pa0, bf16x8 pa1, bf16x8 pa2, bf16x8 pa3) {
  pv_one<0>(o[0], vb, pa0, pa1, pa2, pa3); pv_one<1>(o[1], vb, pa0, pa1, pa2, pa3); pv_one<2>(o[2], vb, pa0, pa1, pa2, pa3); pv_one<3>(o[3], vb, pa0, pa1, pa2, pa3);
}

template <int LDQ, int LDK, int LDO>
__device__ __forceinline__ void attn_dense_body(const bf16* __restrict__ Qb, const bf16* __restrict__ Kh, const bf16* __restrict__ Vh, bf16* __restrict__ Ob, int seq, char* lds) {
  constexpr int SDEPTH = 2;
  const int tid = pg8::otid(), wid = tid >> 6, lane = tid & 63, r32 = lane & 31, hi = lane >> 5;
  bf16* V_lds = (bf16*)lds; bf16* K_lds = (bf16*)(lds + 2 * SHM_V);
  float* ws = (float*)(lds + 2 * SHM_V + 2 * SHM_K) + wid * 64; float* li_l = ws; float* al_l = ws + 32;
  float m_reg = -1e30f, l_reg = 0; f32x16 o[4] = {}; bf16x8 qr[8];
  const bf16* Qw = Qb + (long)(wid * QBLK + r32) * LDQ + hi * 8;
#pragma unroll
  for (int d0 = 0; d0 < 8; ++d0) qr[d0] = ld8(Qw + d0 * 16);
  const int sr = tid >> 4, sc = (tid & 15) * 8, vst0 = v_st(sr, sc), vst1 = v_st(32 + sr, sc);
  const int vb0 = (int)(uintptr_t)V_lds + v_rd_base(lane);
  struct { bf16x8 vs0, vs1, ks0, ks1; } sr_[SDEPTH];
#define SLOAD(i, k0) do { sr_[i].vs0 = ld8(&Vh[(long)((k0) + sr) * LDK + sc]); sr_[i].vs1 = ld8(&Vh[(long)((k0) + 32 + sr) * LDK + sc]); \
    sr_[i].ks0 = ld8(&Kh[(long)((k0) + sr) * LDK + sc]); sr_[i].ks1 = ld8(&Kh[(long)((k0) + 32 + sr) * LDK + sc]); } while (0)
#define SWRITE(b, i) do { *(bf16x8*)((char*)V_lds + (b) * SHM_V + vst0) = sr_[i].vs0;          \
    *(bf16x8*)((char*)V_lds + (b) * SHM_V + vst1) = sr_[i].vs1; int kc = sc * 2;               \
    *(bf16x8*)((char*)K_lds + (b) * SHM_K + KSWZ(sr, kc)) = sr_[i].ks0;                       \
    *(bf16x8*)((char*)K_lds + (b) * SHM_K + KSWZ(32 + sr, kc)) = sr_[i].ks1; } while (0)
#define SWAIT() asm volatile("s_waitcnt vmcnt(4)" ::: "memory")
#define RESC(a) do { if (__any((a) < 1.f)) { if (hi == 0) al_l[r32] = (a); asm volatile("s_waitcnt lgkmcnt(0)" ::: "memory"); \
    for (int d = 0; d < 4; ++d) for (int r = 0; r < 16; ++r) o[d][r] *= al_l[crow(r, hi)]; } } while (0)
  f32x16 pA0, pA1, pB0, pB1; float mnA, mnB, alA, alB; bf16x8 pa0, pa1, pa2, pa3; const int NT = seq / KVBLK;
  constexpr int SE = 0, SO = SDEPTH - 1;
  SLOAD(SE, 0); asm volatile("s_waitcnt vmcnt(0)" ::: "memory"); SWRITE(0, SE); __syncthreads();
  qkt(pA0, pA1, K_lds, qr, r32, hi); partialSM(pA0, pA1, m_reg, mnA, alA);
  SLOAD(SO, KVBLK); if (2 < NT) SLOAD(SE, 2 * KVBLK);
  SWAIT(); SWRITE(1, SO); __syncthreads();
  for (int j = 1; j + 1 < NT; j += 2) {
    SBAR(); qkt(pB0, pB1, (bf16*)((char*)K_lds + SHM_K), qr, r32, hi);
    finishSM(pA0, pA1, alA, l_reg, pa0, pa1, pa2, pa3); SBAR();
    SLOAD(SO, (j + SDEPTH) * KVBLK); SBAR();
    pv_d0(o, vb0, pa0, pa1, pa2, pa3); partialSM(pB0, pB1, m_reg, mnB, alB);
    __syncthreads(); SWAIT(); SWRITE(0, SE);
    RESC(alB); __syncthreads();
    SBAR(); qkt(pA0, pA1, K_lds, qr, r32, hi);
    finishSM(pB0, pB1, alB, l_reg, pa0, pa1, pa2, pa3); SBAR();
    if (j + 3 < NT) SLOAD(SE, (j + 1 + SDEPTH) * KVBLK); SBAR();
    pv_d0(o, vb0 + (int)SHM_V, pa0, pa1, pa2, pa3); partialSM(pA0, pA1, m_reg, mnA, alA);
    __syncthreads(); SWAIT(); SWRITE(1, SO);
    RESC(alA); __syncthreads();
  }
  SBAR(); qkt(pB0, pB1, (bf16*)((char*)K_lds + SHM_K), qr, r32, hi);
  finishSM(pA0, pA1, alA, l_reg, pa0, pa1, pa2, pa3); SBAR();
  pv_d0(o, vb0, pa0, pa1, pa2, pa3); partialSM(pB0, pB1, m_reg, mnB, alB);
  __syncthreads(); RESC(alB);
  finishSM(pB0, pB1, alB, l_reg, pa0, pa1, pa2, pa3); SBAR();
  pv_d0(o, vb0 + (int)SHM_V, pa0, pa1, pa2, pa3);
  if (hi == 0) li_l[r32] = l_reg; asm volatile("s_waitcnt lgkmcnt(0)" ::: "memory");
  float rli[16];
#pragma unroll
  for (int r = 0; r < 16; ++r) rli[r] = __builtin_amdgcn_rcpf(li_l[crow(r, hi)]);
  bf16* Ow = Ob + (long)(wid * QBLK) * LDO;
#pragma unroll
  for (int r = 0; r < 16; ++r) { int orow = crow(r, hi);
#pragma unroll
    for (int d0 = 0; d0 < 4; ++d0) { const float v = o[d0][r] * rli[r]; Ow[(long)orow * LDO + d0 * 32 + r32] = (bf16)(cvtpk(v, v) & 0xffffu); } }
#undef SLOAD
#undef SWRITE
#undef SWAIT
}

__device__ __forceinline__ void dil_unit(const bf16* __restrict__ proj, float* __restrict__ og, float* __restrict__ lse, int g, int h, int res, int q0, char* lds) {
  const int d = (g == 0) ? 1 : (g == 1 ? 4 : 16), L = SEQ / d;
  const int tid = pg8::otid(), wid = tid >> 6, lane = tid & 63, r32 = lane & 31, hi = lane >> 5;
  bf16* V_lds = (bf16*)lds; bf16* K_lds = (bf16*)(lds + 2 * SHM_V);
  float* ws = (float*)(lds + 2 * SHM_V + 2 * SHM_K) + wid * 64; float* li_l = ws; float* al_l = ws + 32;
  const int colb = g * 512 + h * 128;
  const float slope = exp2f(-8.0f * (float)(g * 4 + h + 1) / 12.0f);
  const float sl2 = slope * (float)d * LOG2E;
  constexpr float C = SCALE * LOG2E;
  float m_reg = -1e30f, l_reg = 0; f32x16 o[4] = {}; bf16x8 qr[8];
  const int wq0 = q0 + wid * QBLK, qj = wq0 + r32;
  { const bf16* Qw = proj + (size_t)((size_t)qj * d + res) * INW + C_AQ + colb + hi * 8;
#pragma unroll
    for (int d0 = 0; d0 < 8; ++d0) qr[d0] = ld8(Qw + d0 * 16); }
  const int sr = tid >> 4, sc = (tid & 15) * 8, vst0 = v_st(sr, sc), vst1 = v_st(32 + sr, sc);
  const int vb0 = (int)(uintptr_t)V_lds + v_rd_base(lane);
  bf16x8 vs0, vs1, ks0, ks1;
#define DLOAD(kt) do { int ka = q0 - 64 + 64 * (kt) + sr, kb = ka + 32; ka = ka < 0 ? 0 : (ka > L - 1 ? L - 1 : ka); kb = kb < 0 ? 0 : (kb > L - 1 ? L - 1 : kb); \
    const bf16* pa_ = proj + (size_t)((size_t)ka * d + res) * INW + colb + sc; const bf16* pb_ = proj + (size_t)((size_t)kb * d + res) * INW + colb + sc; \
    vs0 = ld8(pa_ + C_AV); vs1 = ld8(pb_ + C_AV); ks0 = ld8(pa_ + C_AK); ks1 = ld8(pb_ + C_AK); } while (0)
#define DWRITE(b) do { *(bf16x8*)((char*)V_lds + (b) * SHM_V + vst0) = vs0; *(bf16x8*)((char*)V_lds + (b) * SHM_V + vst1) = vs1; const int kc = sc * 2; \
    *(bf16x8*)((char*)K_lds + (b) * SHM_K + KSWZ(sr, kc)) = ks0; *(bf16x8*)((char*)K_lds + (b) * SHM_K + KSWZ(32 + sr, kc)) = ks1; } while (0)
  DLOAD(0);
  const int kt_lo = wid >> 1;
  for (int kt = 0; kt < 6; ++kt) {
    const int b = kt & 1;
    asm volatile("s_waitcnt vmcnt(0)" ::: "memory"); DWRITE(b);
    if (kt + 1 < 6) DLOAD(kt + 1);
    __syncthreads();
    if (kt >= kt_lo && kt <= kt_lo + 2) {
      f32x16 p0, p1;
      qkt(p0, p1, (const bf16*)((const char*)K_lds + b * SHM_K), qr, r32, hi);
      const int k0 = q0 - 64 + 64 * kt;
      float pmax = -INFINITY;
#pragma unroll
      for (int r = 0; r < 16; ++r) {
        const int kj0 = k0 + crow(r, hi), kj1 = kj0 + 32; const int a0 = abs(kj0 - qj), a1 = abs(kj1 - qj);
        const bool v0 = (a0 <= 64) && (kj0 >= 0) && (kj0 < L), v1 = (a1 <= 64) && (kj1 >= 0) && (kj1 < L);
        p0[r] = v0 ? fmaf(p0[r], C, -sl2 * (float)a0) : -INFINITY; p1[r] = v1 ? fmaf(p1[r], C, -sl2 * (float)a1) : -INFINITY;
        pmax = fmaxf(pmax, fmaxf(p0[r], p1[r])); }
      { auto rr = __builtin_amdgcn_permlane32_swap(__float_as_uint(pmax), __float_as_uint(pmax), false, false);
        pmax = fmaxf(__uint_as_float(rr[0]), __uint_as_float(rr[1])); }
      const float mn = fmaxf(m_reg, pmax); const float alpha = __builtin_amdgcn_exp2f(m_reg - mn); m_reg = mn;
      float ps = 0.f;
#pragma unroll
      for (int r = 0; r < 16; ++r) { p0[r] = __builtin_amdgcn_exp2f(p0[r] - mn); p1[r] = __builtin_amdgcn_exp2f(p1[r] - mn); ps += p0[r] + p1[r]; }
      { auto rr = __builtin_amdgcn_permlane32_swap(__float_as_uint(ps), __float_as_uint(ps), false, false);
        ps = __uint_as_float(rr[0]) + __uint_as_float(rr[1]); }
      l_reg = l_reg * alpha + ps;
      RESC(alpha);
      bf16x8 pa0, pa1, pa2, pa3;
      PK4(p0, 0, pa0); PK4(p0, 8, pa1); PK4(p1, 0, pa2); PK4(p1, 8, pa3);
      pv_d0(o, vb0 + b * (int)SHM_V, pa0, pa1, pa2, pa3);
    }
  }
  if (hi == 0) { li_l[r32] = l_reg; lse[(size_t)((size_t)qj * d + res) * 12 + g * 4 + h] = (m_reg + __log2f(l_reg)) * LN2; }
  asm volatile("s_waitcnt lgkmcnt(0)" ::: "memory");
#pragma unroll
  for (int r = 0; r < 16; ++r) { const int orow = crow(r, hi); const float rl = __builtin_amdgcn_rcpf(li_l[orow]);
    float* Ow = og + (size_t)((size_t)(wq0 + orow) * d + res) * 1536 + colb + r32;
#pragma unroll
    for (int d0 = 0; d0 < 4; ++d0) Ow[d0 * 32] = o[d0][r] * rl; }
  __syncthreads();
#undef DLOAD
#undef DWRITE
}
#undef RESC
#undef PK4
#undef KSWZ
#undef SBAR
}

constexpr int NWAVES = 8;
constexpr int N_PHASES = 26;
constexpr size_t MiB = 1u << 20;
constexpr size_t WS_CTL = 0, CTL_ZERO_BYTES = 1 * MiB;
constexpr size_t WS_ROPE = 1 * MiB;
constexpr size_t WS_WIN = 2 * MiB;
constexpr size_t WS_WBR = WS_WIN + 44 * MiB;
constexpr size_t WS_WOUT = WS_WBR + 8 * MiB;
constexpr size_t WS_WFF1 = WS_WOUT + 8 * MiB;
constexpr size_t WS_WFF2 = WS_WFF1 + 32 * MiB;
constexpr size_t WS_HB = WS_WFF2 + 32 * MiB;
constexpr size_t WS_PROJ = WS_HB + 64 * MiB;
constexpr size_t WS_QR = WS_PROJ + 352 * MiB;
constexpr size_t WS_KV = WS_QR + 48 * MiB;
constexpr size_t WS_OG = WS_KV + 32 * MiB;
constexpr size_t WS_LSE = WS_OG + 96 * MiB;
constexpr size_t WS_Y = WS_LSE + 1 * MiB;
constexpr size_t WS_END = WS_Y + 64 * MiB;
constexpr int CW_BAR = 4096;

constexpr int RING_OFF = 0, RING_BYTES = 131072;
constexpr int LDSCTL_OFF = RING_BYTES, MISC_OFF = LDSCTL_OFF + 320;
constexpr int LDS_BYTES = 147456;

#define GAS __attribute__((address_space(1)))
#define LAS __attribute__((address_space(3)))
typedef unsigned short bf16;
typedef unsigned v4u __attribute__((ext_vector_type(4)));
typedef float f32x4 __attribute__((ext_vector_type(4)));
typedef short bf16x8 __attribute__((ext_vector_type(8)));
typedef GAS unsigned gu32;
typedef GAS unsigned long long gu64;
#define RLX_AGENT __ATOMIC_RELAXED, __HIP_MEMORY_SCOPE_AGENT
#define LDS_WAIT() asm volatile("s_waitcnt lgkmcnt(0)" ::: "memory")
#define VM_WAIT() asm volatile("s_waitcnt vmcnt(0)" ::: "memory")
__device__ __forceinline__ unsigned long long rt() { return __builtin_amdgcn_s_memrealtime(); }
__device__ __forceinline__ unsigned f2bf(float f) { unsigned u = __builtin_bit_cast(unsigned, f); return (u + 0x7fffu + ((u >> 16) & 1u)) >> 16; }
__device__ __forceinline__ unsigned pk2(float lo, float hi) { return f2bf(lo) | (f2bf(hi) << 16); }

#define XB_TMO      128
#define XB_XCNT(j)  (256  + 64 * (j))
#define XB_XSUB(j)  (1280 + 64 * (j))
#define XB_XGEN(j)  (2304 + 64 * (j))
#define XB_TOP      3328
#define XB_TOPGEN   3392
#define XCD_BAR_WORDS 3456
#define XB_SPIN_CAP (1u << 18)

__device__ __forceinline__ unsigned xb_ld(unsigned* p)              { return __hip_atomic_load(p, __ATOMIC_RELAXED, __HIP_MEMORY_SCOPE_AGENT); }
__device__ __forceinline__ unsigned xb_add(unsigned* p, unsigned v) { return __hip_atomic_fetch_add(p, v, __ATOMIC_RELAXED, __HIP_MEMORY_SCOPE_AGENT); }
__device__ __forceinline__ unsigned xb_xcc_id() { return (unsigned)__builtin_amdgcn_s_getreg((3 << 11) | 20) & 0xFu; }
#define XB_SPIN(cond, bar) do { unsigned _sp = 0; while (cond) { __builtin_amdgcn_s_sleep(1); \
    if ((++_sp & 255u) == 0u) { if (xb_ld(&(bar)[XB_TMO])) break; if (_sp > XB_SPIN_CAP) { atomicAdd(&(bar)[XB_TMO], 1u); break; } } } } while (0)

struct XcdBarrier {
    unsigned* bar; unsigned x;
    volatile LAS unsigned* st;
};

__device__ __forceinline__ XcdBarrier xcd_barrier_post(unsigned* bar, volatile LAS unsigned* st) {
    XcdBarrier b; b.bar = bar; b.x = xb_xcc_id(); b.st = st;
    if (threadIdx.x == 0) (void)xb_add(&bar[XB_XCNT(b.x)], 1u);
    return b;
}
__device__ __forceinline__ void xcd_barrier_complete(unsigned* bar, unsigned x, unsigned& nloc, unsigned& nx) {
    const unsigned G = gridDim.x * gridDim.y * gridDim.z;
    unsigned sum, cnt, mine, sp = 0u;
    for (;;) {
        sum = 0u; cnt = 0u; mine = 0u;
#pragma unroll
        for (unsigned j = 0; j < 16; ++j) { const unsigned c = xb_ld(&bar[XB_XCNT(j)]); sum += c; cnt += (c > 0u) ? 1u : 0u; mine = (j == x) ? c : mine; }
        if (sum == G) break;
        __builtin_amdgcn_s_sleep(1);
        if ((++sp & 255u) == 0u) { if (xb_ld(&bar[XB_TMO])) break; if (sp > XB_SPIN_CAP) { atomicAdd(&bar[XB_TMO], 1u); break; } }
    }
    nloc = mine > 0u ? mine : 1u; nx = cnt > 0u ? cnt : 1u;
}

__device__ __forceinline__ void xcd_barrier(const XcdBarrier& b) {
    asm volatile("s_waitcnt vmcnt(0)" ::: "memory");
    __syncthreads();
    if (threadIdx.x == 0) {
        unsigned* bar = b.bar;
        __builtin_amdgcn_s_waitcnt(0);
        unsigned nloc = b.st[0], nx = b.st[1];
        if (nloc == 0u) { xcd_barrier_complete(bar, b.x, nloc, nx); b.st[0] = nloc; b.st[1] = nx; }
        const unsigned old = xb_add(&bar[XB_XSUB(b.x)], 1u);
        const unsigned gen = old / nloc;
        if (old + 1u == (gen + 1u) * nloc) {
            __builtin_amdgcn_fence(__ATOMIC_RELEASE, "agent");
            asm volatile("s_waitcnt vmcnt(0)" ::: "memory");
            const unsigned og = xb_add(&bar[XB_TOP], 1u);
            const unsigned tg = og / nx;
            if (og + 1u == (tg + 1u) * nx) xb_add(&bar[XB_TOPGEN], 1u);
            else XB_SPIN(xb_ld(&bar[XB_TOPGEN]) == tg, bar);
            __builtin_amdgcn_fence(__ATOMIC_ACQUIRE, "agent");
            xb_add(&bar[XB_XGEN(b.x)], 1u);
            asm volatile("s_waitcnt vmcnt(0)" ::: "memory");
        } else {
            XB_SPIN(xb_ld(&bar[XB_XGEN(b.x)]) == gen, bar);
            __builtin_amdgcn_fence(__ATOMIC_ACQUIRE, "agent");
            asm volatile("s_waitcnt vmcnt(0)" ::: "memory");
        }
    }
    __syncthreads();
}


__device__ __forceinline__ float wave_sum(float v) {
#pragma unroll
    for (int o = 1; o < 64; o <<= 1) v += __shfl_xor(v, o);
    return v;
}
__device__ __forceinline__ void p0_transpose_item(const float* W, int K, int N, bf16* WT, const float* gk, LAS float* scr, int item, int lane) {
    const int nblk = N / 32, kb = item / nblk, nb = item % nblk, k0 = 64 * kb, n0 = 32 * nb;
#pragma unroll 8
    for (int i = 0; i < 32; ++i) { const int kk = 2 * i + (lane >> 5); float w = W[(size_t)(k0 + kk) * N + n0 + (lane & 31)]; if (gk) w *= gk[k0 + kk]; scr[kk * 33 + (lane & 31)] = w; }
    LDS_WAIT(); asm volatile("" ::: "memory");
    const int c = lane & 7;
#pragma unroll
    for (int j = 0; j < 4; ++j) { const int n = (lane >> 3) + 8 * j; const LAS float* s = scr + (8 * c) * 33 + n;
        v4u o; o.x = pk2(s[0 * 33], s[1 * 33]); o.y = pk2(s[2 * 33], s[3 * 33]); o.z = pk2(s[4 * 33], s[5 * 33]); o.w = pk2(s[6 * 33], s[7 * 33]);
        *(GAS v4u*)(WT + (size_t)(n0 + n) * K + k0 + 8 * c) = o; }
    LDS_WAIT(); asm volatile("" ::: "memory");
}
__device__ __forceinline__ void rms_row_to_bf16(const float* xrow, const float* g, bf16* orow, int lane) {
    const GAS f32x4* xr = (const GAS f32x4*)xrow + lane; const GAS f32x4* gr = (const GAS f32x4*)g + lane;
    f32x4 v[8]; float s = 0.f;
#pragma unroll
    for (int j = 0; j < 8; ++j) { v[j] = xr[64 * j]; s += (v[j].x * v[j].x + v[j].y * v[j].y) + (v[j].z * v[j].z + v[j].w * v[j].w); }
    const float r = 1.0f / sqrtf(wave_sum(s) * (1.f / DM) + RMS_EPS);
    GAS unsigned long long* o8 = (GAS unsigned long long*)orow + lane;
#pragma unroll
    for (int j = 0; j < 8; ++j) { const f32x4 gg = gr[64 * j]; o8[64 * j] = (unsigned long long)pk2(v[j].x * r * gg.x, v[j].y * r * gg.y) | ((unsigned long long)pk2(v[j].z * r * gg.z, v[j].w * r * gg.w) << 32); }
}
__device__ __forceinline__ void rms_row_f32_inplace(float* xrow, const float* g, int lane) {
    GAS f32x4* xr = (GAS f32x4*)xrow + lane; const GAS f32x4* gr = (const GAS f32x4*)g + lane;
    f32x4 v[8]; float s = 0.f;
#pragma unroll
    for (int j = 0; j < 8; ++j) { v[j] = xr[64 * j]; s += (v[j].x * v[j].x + v[j].y * v[j].y) + (v[j].z * v[j].z + v[j].w * v[j].w); }
    const float r = 1.0f / sqrtf(wave_sum(s) * (1.f / DM) + RMS_EPS);
#pragma unroll
    for (int j = 0; j < 8; ++j) { const f32x4 gg = gr[64 * j]; xr[64 * j] = (f32x4){v[j].x * r * gg.x, v[j].y * r * gg.y, v[j].z * r * gg.z, v[j].w * r * gg.w}; }
}
__device__ __forceinline__ void sincos_d(double a, double& s, double& c) {
    const double TWO_PI = 6.283185307179586476925286766559;
    const double k = rint(a / TWO_PI); const double x = a - k * TWO_PI, x2 = x * x;
    double ts = 1.0, tc = 1.0, ss = 1.0, cc = 1.0;
#pragma unroll 1
    for (int n = 1; n <= 16; ++n) { tc = -tc * x2 / (double)((2 * n - 1) * (2 * n)); ts = -ts * x2 / (double)((2 * n) * (2 * n + 1)); cc += tc; ss += ts; }
    s = ss * x; c = cc;
}

struct Args { const float* in[12]; float* out; unsigned char* ws; int ph_lo, ph_hi, li, pad; };

__global__ void __launch_bounds__(NWAVES * 64, 2) enc_fwd(Args args) {
    extern __shared__ __attribute__((aligned(16))) unsigned char lds[];
    LAS unsigned char* ldsl = (LAS unsigned char*)lds;
    volatile LAS unsigned* MISC = (volatile LAS unsigned*)(ldsl + MISC_OFF);
    const int tid = threadIdx.x;
    const int G = gridDim.x, bx = blockIdx.x;
    const int vcu = (G % 8 == 0) ? (bx % 8) * (G / 8) + bx / 8 : bx;
    unsigned char* ws = args.ws;
    gu32* ctl = (gu32*)(ws + WS_CTL);
    for (int u = tid; u < (LDS_BYTES - LDSCTL_OFF) / 4; u += NWAVES * 64) ((LAS unsigned*)(ldsl + LDSCTL_OFF))[u] = 0u;
    __syncthreads();
    XcdBarrier bar; bar.bar = (unsigned*)(ctl + CW_BAR); bar.x = 0; bar.st = nullptr;
    const int lo = args.ph_lo, hi = args.ph_hi;
    if (hi - lo > 1) bar = xcd_barrier_post((unsigned*)(ctl + CW_BAR) + args.li * XCD_BAR_WORDS, MISC + 8);
#define IN(k) (lo <= (k) && (k) < hi)
#define SEAM(k) do { if (IN((k) + 1)) xcd_barrier(bar); } while (0)

    const float* x_prompt = args.in[0]; const float* x_sample = args.in[1];
    const float* g_mix = args.in[2]; const float* w_in = args.in[3]; const float* g_q = args.in[4]; const float* g_k = args.in[5];
    const float* w_branch = args.in[6]; const float* w_out = args.in[7]; const float* g_mlp = args.in[8]; const float* w_ff1 = args.in[9]; const float* w_ff2 = args.in[10];
    const float* g_final = args.in[11];
    bf16* Win_t = (bf16*)(ws + WS_WIN); bf16* Wbr_t = (bf16*)(ws + WS_WBR); bf16* Wout_t = (bf16*)(ws + WS_WOUT); bf16* Wff1_t = (bf16*)(ws + WS_WFF1); bf16* Wff2_t = (bf16*)(ws + WS_WFF2);
    bf16* HB = (bf16*)(ws + WS_HB); bf16* PROJ = (bf16*)(ws + WS_PROJ); bf16* UB = (bf16*)(ws + WS_PROJ);
    bf16* QR = (bf16*)(ws + WS_QR); bf16* KV = (bf16*)(ws + WS_KV); float* OG = (float*)(ws + WS_OG); bf16* MG = (bf16*)(ws + WS_OG);
    float* LSE = (float*)(ws + WS_LSE); bf16* YB = (bf16*)(ws + WS_Y); bf16* H2B = (bf16*)(ws + WS_Y);
    float2* ROPE = (float2*)(ws + WS_ROPE);
    const int NGW = G * NWAVES, NGT = NGW * 64;
#define LANE_IDS() const int tid_ = pg8::otid(), lane = tid_ & 63, wave = __builtin_amdgcn_readfirstlane(tid_ >> 6), gw = vcu * NWAVES + wave, gt = gw * 64 + lane; (void)gt; (void)gw; (void)lane

    if (IN(0)) {
        LANE_IDS();
        LAS float* scr = (LAS float*)(ldsl + RING_OFF + wave * 16384);
        constexpr int I_IN = (DM / 64) * (INW / 32), I_SQ = (DM / 64) * (DM / 32), I_F1 = (DM / 64) * (DFF / 32), I_F2 = (DFF / 64) * (DM / 32);
        constexpr int NITEMS = I_IN + 2 * I_SQ + I_F1 + I_F2;
        for (int it = gw; it < NITEMS; it += NGW) {
            int r = it;
            if (r < I_IN) { p0_transpose_item(w_in, DM, INW, Win_t, nullptr, scr, r, lane); continue; } r -= I_IN;
            if (r < I_SQ) { p0_transpose_item(w_branch, DM, DM, Wbr_t, nullptr, scr, r, lane); continue; } r -= I_SQ;
            if (r < I_SQ) { p0_transpose_item(w_out, DM, DM, Wout_t, nullptr, scr, r, lane); continue; } r -= I_SQ;
            if (r < I_F1) { p0_transpose_item(w_ff1, DM, DFF, Wff1_t, g_mlp, scr, r, lane); continue; } r -= I_F1;
            p0_transpose_item(w_ff2, DFF, DM, Wff2_t, nullptr, scr, r, lane);
        }
        for (int i = gt; i < 256 * 32; i += NGT) {
            const int pos = i >> 5, f = i & 31;
            double iv = 1.0; for (int q = 0; q < f; ++q) iv *= 0.7498942093324559;
            const float invf = (float)iv;
            const float ang = (float)pos * invf; double s, c; sincos_d((double)ang, s, c);
            ROPE[i] = make_float2((float)c, (float)s);
        }
        for (int m = gw; m < SEQ; m += NGW) rms_row_to_bf16(x_prompt + (size_t)m * DM, g_mix, HB + (size_t)m * DM, lane);
        SEAM(0);
    }

    for (int s = 0; s < NSEQ; ++s) {
        const int pb = 1 + 8 * s;
        const float* xs = (s == 0) ? x_prompt : x_sample + (size_t)(s - 1) * SEQ * DM;
        float* outs = args.out + (size_t)s * SEQ * DM;

        if (IN(pb + 0)) {
            pg8::Gemm g{HB, Win_t, SEQ, INW, DM}; pg8::StaticOrder S; S.init(SEQ, INW, G, bx);
            pg8::EpiBf16<0> E{PROJ, INW};
            pg8::gemm_phase<pg8::EpiBf16<0>, pg8::StaticOrder, true, true>(ldsl + RING_OFF, g, S, E);
            SEAM(pb + 0);
        }
        if (IN(pb + 1)) {
            {   LANE_IDS();
                const int j = gt & 7, a = j >> 2, jj = j & 3;
                for (int item = gt >> 3; item < SEQ * 16; item += NGT >> 3) {
                    const int t = item >> 4, hh = item & 15;
                    const bf16* src; bf16* dst; const float* gg;
                    if (hh < 12) { src = PROJ + (size_t)t * INW + C_BQ + hh * 128; dst = QR + (size_t)t * 1536 + hh * 128; gg = g_q; }
                    else { src = PROJ + (size_t)t * INW + C_BK + (hh - 12) * 128; dst = KV + (size_t)t * 1024 + (hh - 12) * 128; gg = g_k; }
                    const int o1 = 64 * a + 8 * jj, o2 = o1 + 32;
                    const v4u w1 = *(const GAS v4u*)(src + o1), w2 = *(const GAS v4u*)(src + o2);
                    float x1[8], x2[8]; float ss = 0.f;
#pragma unroll
                    for (int e = 0; e < 4; ++e) { x1[2 * e] = pg8::bf_lo(w1[e]); x1[2 * e + 1] = pg8::bf_hi(w1[e]); x2[2 * e] = pg8::bf_lo(w2[e]); x2[2 * e + 1] = pg8::bf_hi(w2[e]); }
#pragma unroll
                    for (int e = 0; e < 8; ++e) ss += x1[e] * x1[e] + x2[e] * x2[e];
                    ss += __shfl_xor(ss, 1); ss += __shfl_xor(ss, 2); ss += __shfl_xor(ss, 4);
                    const float rinv = 1.0f / sqrtf(ss * (1.f / 128.f) + RMS_EPS);
                    const int pos = (a == 0) ? (t >> 6) : (t & 63);
                    const float2* rt_ = ROPE + pos * 32 + 8 * jj;
                    float y1[8], y2[8];
#pragma unroll
                    for (int e = 0; e < 8; ++e) { const float2 cs = rt_[e]; const float u1 = x1[e] * rinv * gg[o1 + e], u2 = x2[e] * rinv * gg[o2 + e];
                        y1[e] = u1 * cs.x - u2 * cs.y; y2[e] = u2 * cs.x + u1 * cs.y; }
                    v4u q1, q2;
#pragma unroll
                    for (int e = 0; e < 4; ++e) { q1[e] = pk2(y1[2 * e], y1[2 * e + 1]); q2[e] = pk2(y2[2 * e], y2[2 * e + 1]); }
                    *(GAS v4u*)(dst + o1) = q1; *(GAS v4u*)(dst + o2) = q2;
                }
                for (int item = gt; item < SEQ * 64; item += NGT) { const int t = item >> 6, c = item & 63;
                    *(GAS v4u*)(KV + (size_t)t * 1024 + 512 + 8 * c) = *(const GAS v4u*)(PROJ + (size_t)t * INW + C_BV + 8 * c); }
            }
            __syncthreads();
            for (int u = vcu; u < 768; u += G) {
                const int g = u >> 8, h = (u >> 6) & 3, rb = u & 63;
                const int d = (g == 0) ? 1 : (g == 1 ? 4 : 16), nblk = (SEQ / d) / 256;
                const int res = rb / nblk, blk = rb % nblk;
                att::dil_unit((const att::bf16*)PROJ, OG, LSE, g, h, res, blk * 256, (char*)lds + RING_OFF);
            }
            SEAM(pb + 1);
        }
        if (IN(pb + 2)) {
            { LANE_IDS();
            for (int item = gt; item < SEQ * 64; item += NGT) {
                const int t = item >> 6, h = (item >> 4) & 3, c = item & 15;
                const float l0 = LSE[(size_t)t * 12 + h], l1 = LSE[(size_t)t * 12 + 4 + h], l2 = LSE[(size_t)t * 12 + 8 + h];
                const float mx = fmaxf(l0, fmaxf(l1, l2)); float e0 = __expf(l0 - mx), e1 = __expf(l1 - mx), e2 = __expf(l2 - mx);
                const float rs = 1.0f / (e0 + e1 + e2); e0 *= rs; e1 *= rs; e2 *= rs;
                const float* o0 = OG + (size_t)t * 1536 + h * 128 + 8 * c;
                const f32x4 a0 = *(const GAS f32x4*)(o0), a1 = *(const GAS f32x4*)(o0 + 4), b0 = *(const GAS f32x4*)(o0 + 512), b1 = *(const GAS f32x4*)(o0 + 516), c0 = *(const GAS f32x4*)(o0 + 1024), c1 = *(const GAS f32x4*)(o0 + 1028);
                const f32x4 r0 = a0 * e0 + b0 * e1 + c0 * e2, r1 = a1 * e0 + b1 * e1 + c1 * e2;
                v4u w; w.x = pk2(r0.x, r0.y); w.y = pk2(r0.z, r0.w); w.z = pk2(r1.x, r1.y); w.w = pk2(r1.z, r1.w);
                *(GAS v4u*)(YB + (size_t)t * DM + h * 128 + 8 * c) = w;
            } }
            for (int u = vcu; u < 768; u += G) {
                const int hq = u >> 6, qb = u & 63, kvh = hq / 3;
                __syncthreads();
                att::attn_dense_body<1536, 1024, DM>((const att::bf16*)QR + (size_t)qb * 256 * 1536 + hq * 128, (const att::bf16*)KV + kvh * 128, (const att::bf16*)KV + 512 + kvh * 128,
                                                     (att::bf16*)YB + (size_t)qb * 256 * DM + 512 + hq * 128, SEQ, (char*)lds + RING_OFF);
            }
            SEAM(pb + 2);
        }
        if (IN(pb + 3)) {
            __syncthreads();
            pg8::Gemm g{YB, Wbr_t, SEQ, DM, DM}; pg8::StaticOrder S; S.init(SEQ, DM, G, bx);
            pg8::EpiGate E{MG, DM, PROJ, INW, C_GA, C_GB, (unsigned)((size_t)SEQ * INW * 2)};
            pg8::gemm_phase<pg8::EpiGate, pg8::StaticOrder, true, true>(ldsl + RING_OFF, g, S, E);
            SEAM(pb + 3);
        }
        if (IN(pb + 4)) {
            pg8::Gemm g{MG, Wout_t, SEQ, DM, DM}; pg8::StaticOrder S; S.init(SEQ, DM, G, bx);
            pg8::EpiResF32 E{xs, outs, DM};
            pg8::gemm_phase<pg8::EpiResF32, pg8::StaticOrder, true, true>(ldsl + RING_OFF, g, S, E);
            SEAM(pb + 4);
        }
        if (IN(pb + 5)) {
            LANE_IDS();
            for (int m = gw; m < SEQ; m += NGW) {
                const GAS f32x4* xr = (const GAS f32x4*)(outs + (size_t)m * DM) + lane;
                f32x4 v[8]; float ssum = 0.f;
#pragma unroll
                for (int j = 0; j < 8; ++j) { v[j] = xr[64 * j]; ssum += (v[j].x * v[j].x + v[j].y * v[j].y) + (v[j].z * v[j].z + v[j].w * v[j].w); }
                const float r = 1.0f / sqrtf(wave_sum(ssum) * (1.f / DM) + RMS_EPS);
                GAS unsigned long long* o8 = (GAS unsigned long long*)(H2B + (size_t)m * DM) + lane;
#pragma unroll
                for (int j = 0; j < 8; ++j) o8[64 * j] = (unsigned long long)pk2(v[j].x * r, v[j].y * r) | ((unsigned long long)pk2(v[j].z * r, v[j].w * r) << 32);
            }
            if (s + 1 < NSEQ) { const float* xn = x_sample + (size_t)s * SEQ * DM;
                for (int m = gw; m < SEQ; m += NGW) rms_row_to_bf16(xn + (size_t)m * DM, g_mix, HB + (size_t)m * DM, lane); }
            SEAM(pb + 5);
        }
        if (IN(pb + 6)) {
            pg8::Gemm g{H2B, Wff1_t, SEQ, DFF, DM}; pg8::StaticOrder S; S.init(SEQ, DFF, G, bx);
            pg8::EpiBf16<2> E{UB, DFF};
            pg8::gemm_phase<pg8::EpiBf16<2>, pg8::StaticOrder, true, true>(ldsl + RING_OFF, g, S, E);
            SEAM(pb + 6);
        }
        if (IN(pb + 7)) {
            pg8::Gemm g{UB, Wff2_t, SEQ, DM, DFF}; pg8::StaticOrder S; S.init(SEQ, DM, G, bx);
            pg8::EpiResF32 E{outs, outs, DM};
            pg8::gemm_phase<pg8::EpiResF32, pg8::StaticOrder, true, true>(ldsl + RING_OFF, g, S, E);
            SEAM(pb + 7);
        }
    }
    if (IN(25)) {
        LANE_IDS();
        for (int m = gw; m < NSEQ * SEQ; m += NGW) rms_row_f32_inplace(args.out + (size_t)m * DM, g_final, lane);
    }
#undef IN
#undef SEAM
}

extern "C" void kernel_launch(void* const* d_in, const int* in_sizes, int n_in, void* d_out, int out_size, void* d_ws, size_t ws_size, hipStream_t stream) {
    static int grid = 0;
    if (grid == 0) {
        if (n_in != 12 || ws_size < WS_END) { fprintf(stderr, "kernel_launch: expected 12 inputs and >= %zu bytes of workspace; got n_in %d ws %zu\n", (size_t)WS_END, n_in, ws_size); grid = -1; return; }
        int dev = 0, cus = 0, per_cu = 0;
        if (hipGetDevice(&dev) != hipSuccess || hipDeviceGetAttribute(&cus, hipDeviceAttributeMultiprocessorCount, dev) != hipSuccess) { grid = -1; return; }
        if (hipFuncSetAttribute((const void*)enc_fwd, hipFuncAttributeMaxDynamicSharedMemorySize, LDS_BYTES) != hipSuccess) { fprintf(stderr, "kernel_launch: hipFuncSetAttribute failed\n"); grid = -1; return; }
        if (hipOccupancyMaxActiveBlocksPerMultiprocessor(&per_cu, (const void*)enc_fwd, NWAVES * 64, LDS_BYTES) != hipSuccess || per_cu < 1)
            fprintf(stderr, "kernel_launch: occupancy query reports %d workgroups per CU\n", per_cu);
        (void)hipGetLastError();
        grid = cus;
    }
    if (grid < 0) return;
    if (hipMemsetAsync((char*)d_ws + WS_CTL, 0, CTL_ZERO_BYTES, stream) != hipSuccess) return;
    Args a{};
    for (int i = 0; i < 12; ++i) a.in[i] = (const float*)d_in[i];
    a.out = (float*)d_out; a.ws = (unsigned char*)d_ws;
#if MK_N_LAUNCHES == 1
    a.ph_lo = 0; a.ph_hi = N_PHASES; a.li = 0;
    hipLaunchKernelGGL(enc_fwd, dim3(grid), dim3(NWAVES * 64), LDS_BYTES, stream, a);
#else
    for (int p = 0; p < N_PHASES; ++p) { a.ph_lo = p; a.ph_hi = p + 1; a.li = 0;
        hipLaunchKernelGGL(enc_fwd, dim3(grid), dim3(NWAVES * 64), LDS_BYTES, stream, a); }
#endif
    const hipError_t le = hipPeekAtLastError();
    if (le != hipSuccess) fprintf(stderr, "kernel_launch: launch failed: %s\n", hipGetErrorName(le));
}
```

```cpp
#include <hip/hip_runtime.h>
#include <cstdio>
#include <cstdint>

#ifndef MK_N_LAUNCHES
#define MK_N_LAUNCHES 1
#endif

namespace pg8 {
#define PG8_LAS __attribute__((address_space(3)))
typedef unsigned short bf16_t;
typedef short bf16x8 __attribute__((ext_vector_type(8)));
typedef float f32x4 __attribute__((ext_vector_type(4)));
typedef unsigned u32x4 __attribute__((ext_vector_type(4)));
typedef int v8i_t __attribute__((ext_vector_type(8)));
typedef int v4i_t __attribute__((ext_vector_type(4)));
constexpr int BM = 256, BK = 64, HALF = 128, HTB = HALF * BK * 2  , STAGE_BYTES = 8 * HTB, NXCD = 8;

__host__ __device__ __forceinline__ int lds_byte(int r, int c) { const int st = (r >> 4) * 2 + (c >> 5), rr = r & 15, cc = c & 31, ob = rr * 64 + cc * 2; return st * 1024 + (ob ^ (((ob >> 9) & 1) << 5)); }
__host__ __device__ __forceinline__ void stage_rc(int b, int& R, int& C) { const int st = b / 1024, sb = b % 1024, swz = sb ^ (((sb >> 9) & 1) << 5); R = (st >> 1) * 16 + swz / 64; C = (st & 1) * 32 + (swz % 64) / 2; }
__host__ __device__ __forceinline__ int perm32(int rho) { const int n = rho >> 4, i = rho & 15; return 8 * (i >> 2) + 4 * n + (i & 3); }

struct Unit { int pm, pn; };
struct Gemm { const bf16_t* A; const bf16_t* Bt; int M, N, K; };

struct StaticOrder {
    int nM, nN, nwg, G, c, WGM;
    __host__ __device__ void init(int M, int N, int G_, int c_, int wgm = 4) { nM = M / BM; nN = N / BM; nwg = nM * nN; G = G_; c = c_; WGM = wgm; }
    __host__ __device__ bool next(int i, Unit& u) const {
        const long L = (long)i * G + c; if (L >= nwg) return false;
        int wgid = (int)L; { const int q = nwg / NXCD, r = nwg % NXCD, xcd = wgid % NXCD, off = wgid / NXCD; wgid = (xcd < r ? xcd * (q + 1) : r * (q + 1) + (xcd - r) * q) + off; }
        const int nig = WGM * nN, gid = wgid / nig, fm = gid * WGM, gsz = (nM - fm) < WGM ? (nM - fm) : WGM;
        u.pm = fm + ((wgid % nig) % gsz); u.pn = (wgid % nig) / gsz; return true;
    }
    __device__ __forceinline__ void a_ready(const Unit&) const {}
    __device__ __forceinline__ void done(const Unit&) const {}
};


__device__ __forceinline__ int otid() { int t = threadIdx.x; asm volatile("" : "+v"(t)); return t; }
__device__ __forceinline__ unsigned cvt_pk_bf16(float lo, float hi) { unsigned r; asm volatile("v_cvt_pk_bf16_f32 %0, %1, %2" : "=v"(r) : "v"(lo), "v"(hi)); return r; }
__device__ __forceinline__ float bf_lo(unsigned w) { return __uint_as_float(w << 16); }
__device__ __forceinline__ float bf_hi(unsigned w) { return __uint_as_float(w & 0xffff0000u); }

template <int ACT, bool ROWSS = false, int GATE_PN = (1 << 30)> struct EpiBf16 {
    static constexpr bool PERM = true, AFTER_DRAIN = false, HAS_MID = false; static constexpr int MID_T = -1;
    bf16_t* O; int ldc; float osc; const float* rowss;
    __device__ __forceinline__ void mid(f32x4 (&)[2][2][4][2], const Unit&, int, int, int, int) const {}
    __device__ __forceinline__ void operator()(const f32x4 (&acc)[2][2][4][2], const Unit& u, int wr, int wc, int fr, int fq) const {
        const int row0 = u.pm * BM + wr * 64 + fr; const int col0 = u.pn * BM + wc * 32 + 8 * fq;
        float rs[2][4];
#pragma unroll
        for (int ai = 0; ai < 2; ++ai)
#pragma unroll
            for (int m = 0; m < 4; ++m) rs[ai][m] = ROWSS ? rowss[row0 + ai * HALF + m * 16] : osc;
        __builtin_amdgcn_sched_barrier(0);
        if constexpr (ROWSS) {
#pragma unroll
            for (int ai = 0; ai < 2; ++ai)
#pragma unroll
                for (int m = 0; m < 4; ++m) rs[ai][m] = osc * __builtin_amdgcn_rsqf(rs[ai][m] * (1.0f / 2048.0f) + 1e-6f); }
        if (GATE_PN < (1 << 30) && u.pn >= GATE_PN) {
#pragma unroll
            for (int ai = 0; ai < 2; ++ai)
#pragma unroll
                for (int m = 0; m < 4; ++m) { bf16_t* rowp = O + (size_t)(row0 + ai * HALF + m * 16) * ldc + col0; f32x4 r_[2], s_[2];
#pragma unroll
                    for (int n = 0; n < 2; ++n)
#pragma unroll
                        for (int e = 0; e < 4; ++e) { const float ea = __expf(-acc[ai][0][m][n][e] * osc), eb = __expf(-acc[ai][1][m][n][e] * osc);
                            r_[n][e] = 16.f * (1.f + eb) * __builtin_amdgcn_rcpf(1.f + ea); s_[n][e] = __builtin_amdgcn_rcpf(1.f + eb); }
                    u32x4 w; w.x = cvt_pk_bf16(r_[0][0], r_[0][1]); w.y = cvt_pk_bf16(r_[0][2], r_[0][3]); w.z = cvt_pk_bf16(r_[1][0], r_[1][1]); w.w = cvt_pk_bf16(r_[1][2], r_[1][3]);
                    *(u32x4*)(rowp) = w;
                    w.x = cvt_pk_bf16(s_[0][0], s_[0][1]); w.y = cvt_pk_bf16(s_[0][2], s_[0][3]); w.z = cvt_pk_bf16(s_[1][0], s_[1][1]); w.w = cvt_pk_bf16(s_[1][2], s_[1][3]);
                    *(u32x4*)(rowp + HALF) = w; }
            return; }
#pragma unroll
        for (int ai = 0; ai < 2; ++ai)
#pragma unroll
            for (int m = 0; m < 4; ++m) { bf16_t* rowp = O + (size_t)(row0 + ai * HALF + m * 16) * ldc + col0;
#pragma unroll
                for (int bj = 0; bj < 2; ++bj) { f32x4 v0 = acc[ai][bj][m][0] * rs[ai][m], v1 = acc[ai][bj][m][1] * rs[ai][m];
                    if (ACT == 2) {
#pragma unroll
                        for (int e = 0; e < 4; ++e) { float a = fmaxf(v0[e], 0.f), b = fmaxf(v1[e], 0.f); v0[e] = a * a; v1[e] = b * b; } }
                    u32x4 w; w.x = cvt_pk_bf16(v0[0], v0[1]); w.y = cvt_pk_bf16(v0[2], v0[3]); w.z = cvt_pk_bf16(v1[0], v1[1]); w.w = cvt_pk_bf16(v1[2], v1[3]);
                    *(u32x4*)(rowp + bj * HALF) = w; } }
    }
};
struct EpiGate {
    static constexpr bool PERM = true, AFTER_DRAIN = false, HAS_MID = true; static constexpr int MID_T = 4;
    bf16_t* O; int ldc; const bf16_t* G; int ldg, ga0; unsigned gbytes;
    __device__ __forceinline__ void mid(f32x4 (&acc)[2][2][4][2], const Unit& u, int wr, int wc, int fr, int fq) const {
        const __amdgpu_buffer_rsrc_t rs = __builtin_amdgcn_make_buffer_rsrc((void*)G, 0, gbytes, 0x00020000);
        const int voff = ((wr * 64 + fr) * ldg + wc * 32 + 8 * fq) * 2;
        const int sb = (u.pm * BM * ldg + ga0 + u.pn * 2 * BM) * 2;
        u32x4 gr[2][4][2];
#pragma unroll
        for (int ai = 0; ai < 2; ++ai)
#pragma unroll
            for (int m = 0; m < 4; ++m) { const int so = sb + (ai * HALF + m * 16) * ldg * 2;
#pragma unroll
                for (int bj = 0; bj < 2; ++bj) gr[ai][m][bj] = __builtin_amdgcn_raw_buffer_load_b128(rs, voff, so + bj * BM * 2, 0); }
        __builtin_amdgcn_sched_barrier(0);
#pragma unroll
        for (int ai = 0; ai < 2; ++ai)
#pragma unroll
            for (int m = 0; m < 4; ++m)
#pragma unroll
                for (int bj = 0; bj < 2; ++bj) { const u32x4 a = gr[ai][m][bj];
#pragma unroll
                    for (int e = 0; e < 4; ++e) { acc[ai][bj][m][e >> 1][(e & 1) * 2 + 0] *= bf_lo(a[e]); acc[ai][bj][m][e >> 1][(e & 1) * 2 + 1] *= bf_hi(a[e]); } }
        __builtin_amdgcn_sched_barrier(0);
    }
    __device__ __forceinline__ void operator()(const f32x4 (&acc)[2][2][4][2], const Unit& u, int wr, int wc, int fr, int fq) const {
        const __amdgpu_buffer_rsrc_t rs = __builtin_amdgcn_make_buffer_rsrc((void*)G, 0, gbytes, 0x00020000);
        const int voff = ((wr * 64 + fr) * ldg + wc * 32 + 8 * fq) * 2;
        const int sb = (u.pm * BM * ldg + ga0 + u.pn * 2 * BM + HALF) * 2;
        const int row0 = u.pm * BM + wr * 64 + fr; const int col0 = u.pn * BM + wc * 32 + 8 * fq;
        u32x4 gb[2][4][2];
#pragma unroll
        for (int ai = 0; ai < 2; ++ai)
#pragma unroll
            for (int m = 0; m < 4; ++m) { const int so = sb + (ai * HALF + m * 16) * ldg * 2;
#pragma unroll
                for (int bj = 0; bj < 2; ++bj) gb[ai][m][bj] = __builtin_amdgcn_raw_buffer_load_b128(rs, voff, so + bj * BM * 2, 0); }
        __builtin_amdgcn_sched_barrier(0);
#pragma unroll
        for (int ai = 0; ai < 2; ++ai)
#pragma unroll
            for (int m = 0; m < 4; ++m) { const size_t r = (size_t)(row0 + ai * HALF + m * 16);
#pragma unroll
                for (int bj = 0; bj < 2; ++bj) { const u32x4 b = gb[ai][m][bj]; float v[8];
#pragma unroll
                    for (int e = 0; e < 4; ++e) { v[2 * e] = acc[ai][bj][m][e >> 1][(e & 1) * 2 + 0] * bf_lo(b[e]); v[2 * e + 1] = acc[ai][bj][m][e >> 1][(e & 1) * 2 + 1] * bf_hi(b[e]); }
                    int w0 = 0, w1 = 0;
                    constexpr float F_ = 8.f / 2048.f;
                    w0 = __builtin_amdgcn_cvt_pk_fp8_f32(v[0] * F_, v[1] * F_, w0, false); w0 = __builtin_amdgcn_cvt_pk_fp8_f32(v[2] * F_, v[3] * F_, w0, true);
                    w1 = __builtin_amdgcn_cvt_pk_fp8_f32(v[4] * F_, v[5] * F_, w1, false); w1 = __builtin_amdgcn_cvt_pk_fp8_f32(v[6] * F_, v[7] * F_, w1, true);
                    *(unsigned long long*)((unsigned char*)O + r * ldc + col0 + bj * HALF) = (unsigned long long)(unsigned)w0 | ((unsigned long long)(unsigned)w1 << 32); } }
    }
};
struct EpiResF32 {
    static constexpr bool PERM = false, AFTER_DRAIN = false, HAS_MID = false; static constexpr int MID_T = -1;
    const float* base; float* out; int ldc;
    __device__ __forceinline__ void mid(f32x4 (&)[2][2][4][2], const Unit&, int, int, int, int) const {}
    __device__ __forceinline__ void operator()(const f32x4 (&acc)[2][2][4][2], const Unit& u, int wr, int wc, int fr, int fq) const {
        const int row0 = u.pm * BM + wr * 64 + fr; const int col0 = u.pn * BM + wc * 32 + 4 * fq;
#pragma unroll
        for (int ai = 0; ai < 2; ++ai)
#pragma unroll
            for (int m = 0; m < 4; ++m) { const size_t off = (size_t)(row0 + ai * HALF + m * 16) * ldc + col0;
#pragma unroll
                for (int bj = 0; bj < 2; ++bj)
#pragma unroll
                    for (int n = 0; n < 2; ++n) { const f32x4 bs = *(const f32x4*)(base + off + bj * HALF + n * 16); *(f32x4*)(out + off + bj * HALF + n * 16) = bs + acc[ai][bj][m][n]; }
                if (m == 3) asm volatile("" ::: "memory"); }
    }
};

struct EpiResBf16Stats {
    static constexpr bool PERM = true, AFTER_DRAIN = false, HAS_MID = false; static constexpr int MID_T = -1;
    const float* base; bf16_t* xb; int ldc; float* ss; float osc;
    __device__ __forceinline__ void mid(f32x4 (&)[2][2][4][2], const Unit&, int, int, int, int) const {}
    __device__ __forceinline__ void operator()(const f32x4 (&acc)[2][2][4][2], const Unit& u, int wr, int wc, int fr, int fq) const {
        const int row0 = u.pm * BM + wr * 64 + fr; const int col0 = u.pn * BM + wc * 32 + 8 * fq;
#pragma unroll
        for (int ai = 0; ai < 2; ++ai) {
            f32x4 xr[4][2][2];
#pragma unroll
            for (int m = 0; m < 4; ++m) { const size_t off = (size_t)(row0 + ai * HALF + m * 16) * ldc + col0;
#pragma unroll
                for (int bj = 0; bj < 2; ++bj) { xr[m][bj][0] = *(const f32x4*)(base + off + bj * HALF); xr[m][bj][1] = *(const f32x4*)(base + off + bj * HALF + 4); } }
            __builtin_amdgcn_sched_barrier(0);
            float sq[4];
#pragma unroll
            for (int m = 0; m < 4; ++m) { const size_t off = (size_t)(row0 + ai * HALF + m * 16) * ldc + col0; float q = 0.f;
#pragma unroll
                for (int bj = 0; bj < 2; ++bj) { const f32x4 v0 = xr[m][bj][0] + acc[ai][bj][m][0] * osc, v1 = xr[m][bj][1] + acc[ai][bj][m][1] * osc;
                    q += (v0[0] * v0[0] + v0[1] * v0[1]) + (v0[2] * v0[2] + v0[3] * v0[3]) + (v1[0] * v1[0] + v1[1] * v1[1]) + (v1[2] * v1[2] + v1[3] * v1[3]);
                    u32x4 w; w.x = cvt_pk_bf16(v0[0], v0[1]); w.y = cvt_pk_bf16(v0[2], v0[3]); w.z = cvt_pk_bf16(v1[0], v1[1]); w.w = cvt_pk_bf16(v1[2], v1[3]);
                    *(u32x4*)(xb + off + bj * HALF) = w; }
                q += __shfl_xor(q, 16); q += __shfl_xor(q, 32); sq[m] = q; }
            if (fq == 0) {
#pragma unroll
                for (int m = 0; m < 4; ++m) unsafeAtomicAdd(ss + row0 + ai * HALF + m * 16, sq[m]); }
            __builtin_amdgcn_sched_barrier(0); }
    }
};
struct EpiResFromBf16 {
    static constexpr bool PERM = true, AFTER_DRAIN = false, HAS_MID = false; static constexpr int MID_T = -1;
    const bf16_t* xb; float* out; int ldc;
    __device__ __forceinline__ void mid(f32x4 (&)[2][2][4][2], const Unit&, int, int, int, int) const {}
    __device__ __forceinline__ void operator()(const f32x4 (&acc)[2][2][4][2], const Unit& u, int wr, int wc, int fr, int fq) const {
        const int row0 = u.pm * BM + wr * 64 + fr; const int col0 = u.pn * BM + wc * 32 + 8 * fq;
        u32x4 xr[2][4][2];
#pragma unroll
        for (int ai = 0; ai < 2; ++ai)
#pragma unroll
            for (int m = 0; m < 4; ++m) { const size_t off = (size_t)(row0 + ai * HALF + m * 16) * ldc + col0;
#pragma unroll
                for (int bj = 0; bj < 2; ++bj) xr[ai][m][bj] = *(const u32x4*)(xb + off + bj * HALF); }
        __builtin_amdgcn_sched_barrier(0);
#pragma unroll
        for (int ai = 0; ai < 2; ++ai)
#pragma unroll
            for (int m = 0; m < 4; ++m) { const size_t off = (size_t)(row0 + ai * HALF + m * 16) * ldc + col0;
#pragma unroll
                for (int bj = 0; bj < 2; ++bj) { const u32x4 b = xr[ai][m][bj];
                    const f32x4 x0 = {bf_lo(b[0]), bf_hi(b[0]), bf_lo(b[1]), bf_hi(b[1])}, x1 = {bf_lo(b[2]), bf_hi(b[2]), bf_lo(b[3]), bf_hi(b[3])};
                    *(f32x4*)(out + off + bj * HALF) = x0 + acc[ai][bj][m][0]; *(f32x4*)(out + off + bj * HALF + 4) = x1 + acc[ai][bj][m][1]; } }
    }
};
struct EpiResBf16FromBf16Stats {
    static constexpr bool PERM = true, AFTER_DRAIN = false, HAS_MID = false; static constexpr int MID_T = -1;
    const bf16_t* xb; bf16_t* ob; int ldc; float* ss;
    __device__ __forceinline__ void mid(f32x4 (&)[2][2][4][2], const Unit&, int, int, int, int) const {}
    __device__ __forceinline__ void operator()(const f32x4 (&acc)[2][2][4][2], const Unit& u, int wr, int wc, int fr, int fq) const {
        const int row0 = u.pm * BM + wr * 64 + fr; const int col0 = u.pn * BM + wc * 32 + 8 * fq;
        u32x4 xr[2][4][2];
#pragma unroll
        for (int ai = 0; ai < 2; ++ai)
#pragma unroll
            for (int m = 0; m < 4; ++m) { const size_t off = (size_t)(row0 + ai * HALF + m * 16) * ldc + col0;
#pragma unroll
                for (int bj = 0; bj < 2; ++bj) xr[ai][m][bj] = *(const u32x4*)(xb + off + bj * HALF); }
        __builtin_amdgcn_sched_barrier(0);
#pragma unroll
        for (int ai = 0; ai < 2; ++ai) { float sq[4];
#pragma unroll
            for (int m = 0; m < 4; ++m) { const size_t off = (size_t)(row0 + ai * HALF + m * 16) * ldc + col0; float q = 0.f;
#pragma unroll
                for (int bj = 0; bj < 2; ++bj) { const u32x4 b = xr[ai][m][bj];
                    const f32x4 x0 = {bf_lo(b[0]), bf_hi(b[0]), bf_lo(b[1]), bf_hi(b[1])}, x1 = {bf_lo(b[2]), bf_hi(b[2]), bf_lo(b[3]), bf_hi(b[3])};
                    const f32x4 v0 = x0 + acc[ai][bj][m][0], v1 = x1 + acc[ai][bj][m][1];
                    q += (v0[0] * v0[0] + v0[1] * v0[1]) + (v0[2] * v0[2] + v0[3] * v0[3]) + (v1[0] * v1[0] + v1[1] * v1[1]) + (v1[2] * v1[2] + v1[3] * v1[3]);
                    u32x4 w; w.x = cvt_pk_bf16(v0[0], v0[1]); w.y = cvt_pk_bf16(v0[2], v0[3]); w.z = cvt_pk_bf16(v1[0], v1[1]); w.w = cvt_pk_bf16(v1[2], v1[3]);
                    *(u32x4*)(ob + off + bj * HALF) = w; }
                q += __shfl_xor(q, 16); q += __shfl_xor(q, 32); sq[m] = q; }
            if (fq == 0) {
#pragma unroll
                for (int m = 0; m < 4; ++m) unsafeAtomicAdd(ss + row0 + ai * HALF + m * 16, sq[m]); } }
    }
};
template <class Epi, class Sched, bool ALIGN_EPI = false, bool SP2 = false, bool FP8 = false, int WSCALE = 0x7f7f7f7f>
__device__ __forceinline__ void gemm_phase(PG8_LAS unsigned char* lds, const Gemm g, const Sched& S, const Epi& E) {
    const int tid = otid(), wid = __builtin_amdgcn_readfirstlane(tid >> 6), lane = tid & 63, wr = wid >> 2, wc = wid & 3, fr = lane & 15, fq = lane >> 4;
    const int K = g.K, nt = K / BK;
    unsigned voffA[2], voffB[2];
#pragma unroll
    for (int i = 0; i < 2; ++i) { int R, C; stage_rc(tid * 16 + i * 8192, R, C); const int Rb = Epi::PERM ? ((R & ~31) + perm32(R & 31)) : R;
        voffA[i] = (unsigned)(R * K + C) * 2u; voffB[i] = (unsigned)(Rb * K + C) * 2u; }
    const size_t kstep = (size_t)(BK * 2);
    const size_t hstep = (size_t)HALF * K * 2;
    const size_t tstep = 2 * hstep;
    const unsigned ldsw = (unsigned)wid * 1024u;
    const int aoff = lds_byte(wr * 64 + fr, fq * 8), boff = lds_byte(wc * 32 + fr, fq * 8);
#define PG8_SA(b, h) (((b) * 2 + (h)) * HTB)
#define PG8_SB(b, h) ((4 + (b) * 2 + (h)) * HTB)
#define PG8_STAGE(bufoff, gbase, voff) do { _Pragma("unroll") for (int _i = 0; _i < 2; ++_i) \
        __builtin_amdgcn_global_load_lds((const unsigned*)((const char*)(gbase) + (voff)[_i]), (PG8_LAS unsigned*)(lds + (bufoff) + ldsw + _i * 8192), 16, 0, 0); } while (0)
#define PG8_LD32(p) ({ const v4i_t lo_ = *(const PG8_LAS v4i_t*)(p), hi_ = *(const PG8_LAS v4i_t*)((p) + 1024); (v8i_t){lo_[0], lo_[1], lo_[2], lo_[3], hi_[0], hi_[1], hi_[2], hi_[3]}; })
#define PG8_LDA(dst, b, h) do { _Pragma("unroll") for (int m = 0; m < 4; ++m) dst[m] = PG8_LD32(lds + PG8_SA(b, h) + aoff + m * 2048); } while (0)
#define PG8_LDB(dst, b, h) do { _Pragma("unroll") for (int n = 0; n < 2; ++n) dst[n] = PG8_LD32(lds + PG8_SB(b, h) + boff + n * 2048); } while (0)
#define PG8_H(x, k) (bf16x8)__builtin_bit_cast(bf16x8, (v4i_t){x[4 * (k)], x[4 * (k) + 1], x[4 * (k) + 2], x[4 * (k) + 3]})
#define PG8_MMA(ai, bj, At, Bt) do { __builtin_amdgcn_s_setprio(1); if constexpr (FP8) { _Pragma("unroll") for (int m = 0; m < 4; ++m) _Pragma("unroll") for (int n = 0; n < 2; ++n) \
        asm volatile("v_mfma_f32_16x16x128_f8f6f4 %0, %1, %2, %0" : "+v"(acc[ai][bj][m][n]) : "v"(Bt[n]), "v"(At[m])); } else { \
        _Pragma("unroll") for (int m = 0; m < 4; ++m) _Pragma("unroll") for (int n = 0; n < 2; ++n) _Pragma("unroll") for (int k = 0; k < 2; ++k) \
        acc[ai][bj][m][n] = __builtin_amdgcn_mfma_f32_16x16x32_bf16(PG8_H(Bt[n], k), PG8_H(At[m], k), acc[ai][bj][m][n], 0, 0, 0); } __builtin_amdgcn_s_setprio(0); } while (0)
#define PG8_WAIT_V(n) asm volatile("s_waitcnt vmcnt(" #n ")" ::: "memory")
#define PG8_WAIT_L(n) asm volatile("s_waitcnt lgkmcnt(" #n ")" ::: "memory")
#define PG8_BAR __builtin_amdgcn_s_barrier()
#define PG8_SCHED __builtin_amdgcn_sched_barrier(0)
    Unit cur, nxt; int ui = 0;
    if (!S.next(0, cur)) return;
    f32x4 acc[2][2][4][2];
#pragma unroll
    for (int a = 0; a < 2; ++a)
#pragma unroll
        for (int b = 0; b < 2; ++b)
#pragma unroll
            for (int m = 0; m < 4; ++m)
#pragma unroll
                for (int n = 0; n < 2; ++n) acc[a][b][m][n] = (f32x4){0.f, 0.f, 0.f, 0.f};
    v8i_t At[4], B0[2], B1[2];
    const char* cA = (const char*)g.A + (size_t)cur.pm * tstep; const char* cB = (const char*)g.Bt + (size_t)cur.pn * tstep;
    S.a_ready(cur);
    if constexpr (SP2) {
        PG8_STAGE(PG8_SB(0, 0), cB, voffB); PG8_STAGE(PG8_SB(0, 1), cB + hstep, voffB); PG8_STAGE(PG8_SA(0, 0), cA, voffA); PG8_STAGE(PG8_SA(0, 1), cA + hstep, voffA);
        if (wr == 1) PG8_BAR;
        PG8_WAIT_V(2); PG8_BAR;
        PG8_STAGE(PG8_SB(1, 0), cB + kstep, voffB); PG8_STAGE(PG8_SA(1, 0), cA + kstep, voffA); PG8_STAGE(PG8_SB(1, 1), cB + hstep + kstep, voffB);
        PG8_WAIT_V(6); PG8_BAR;
    } else {
        PG8_STAGE(PG8_SB(0, 0), cB, voffB); PG8_STAGE(PG8_SA(0, 0), cA, voffA); PG8_STAGE(PG8_SB(0, 1), cB + hstep, voffB); PG8_STAGE(PG8_SA(0, 1), cA + hstep, voffA);
        if (wr == 1) PG8_BAR;
        PG8_WAIT_V(4); PG8_BAR;
        PG8_STAGE(PG8_SB(1, 0), cB + kstep, voffB); PG8_STAGE(PG8_SA(1, 0), cA + kstep, voffA); PG8_STAGE(PG8_SB(1, 1), cB + hstep + kstep, voffB);
        PG8_WAIT_V(6); PG8_BAR;
    }
    for (;;) {
        const bool has_next = S.next(ui + 1, nxt);
        const char* nA = has_next ? (const char*)g.A + (size_t)nxt.pm * tstep : cA; const char* nB = has_next ? (const char*)g.Bt + (size_t)nxt.pn * tstep : cB;
        for (int t = 0; t < nt; t += 2) {
            const bool last = (t == nt - 2);
            const char* a1 = cA + (size_t)(t + 1) * kstep;
            const char* a2 = last ? nA : cA + (size_t)(t + 2) * kstep; const char* b2 = last ? nB : cB + (size_t)(t + 2) * kstep;
            const char* a3 = a2 + kstep; const char* b3 = b2 + kstep;
            if (last && has_next) S.a_ready(nxt);
            if constexpr (Epi::HAS_MID) { if (t == Epi::MID_T) { E.mid(acc, cur, wr, wc, fr, fq); PG8_WAIT_V(0); } }
            if constexpr (SP2) {
            PG8_LDB(B0, 0, 0); PG8_LDB(B1, 0, 1); PG8_SCHED; PG8_LDA(At, 0, 0); PG8_STAGE(PG8_SA(1, 1), a1 + hstep, voffA);
            PG8_WAIT_V(8); PG8_WAIT_L(0); PG8_BAR; PG8_MMA(0, 0, At, B0); PG8_MMA(0, 1, At, B1); PG8_BAR; PG8_SCHED;
            PG8_LDA(At, 0, 1); PG8_STAGE(PG8_SB(0, 0), b2, voffB); PG8_STAGE(PG8_SB(0, 1), b2 + hstep, voffB); PG8_STAGE(PG8_SA(0, 0), a2, voffA);
            PG8_WAIT_V(8); PG8_WAIT_L(0); PG8_BAR; PG8_MMA(1, 0, At, B0); PG8_MMA(1, 1, At, B1); PG8_BAR; PG8_SCHED;
            PG8_LDB(B0, 1, 0); PG8_LDB(B1, 1, 1); PG8_SCHED; PG8_LDA(At, 1, 0); PG8_STAGE(PG8_SA(0, 1), a2 + hstep, voffA);
            PG8_WAIT_V(8); PG8_WAIT_L(0); PG8_BAR; PG8_MMA(0, 0, At, B0); PG8_MMA(0, 1, At, B1); PG8_BAR; PG8_SCHED;
            PG8_LDA(At, 1, 1); PG8_STAGE(PG8_SB(1, 0), b3, voffB); PG8_STAGE(PG8_SB(1, 1), b3 + hstep, voffB); PG8_STAGE(PG8_SA(1, 0), a3, voffA);
            PG8_WAIT_V(8); PG8_WAIT_L(0); PG8_BAR; PG8_MMA(1, 0, At, B0); PG8_MMA(1, 1, At, B1); PG8_BAR; PG8_SCHED;
            } else {
            PG8_LDB(B0, 0, 0); PG8_SCHED; PG8_LDA(At, 0, 0); PG8_STAGE(PG8_SA(1, 1), a1 + hstep, voffA);
            PG8_WAIT_L(8); PG8_BAR; PG8_WAIT_L(0); PG8_MMA(0, 0, At, B0); PG8_BAR; PG8_SCHED;
            PG8_LDB(B1, 0, 1); PG8_STAGE(PG8_SB(0, 0), b2, voffB);
            PG8_BAR; PG8_WAIT_L(0); PG8_MMA(0, 1, At, B1); PG8_BAR;
            PG8_LDA(At, 0, 1); PG8_STAGE(PG8_SA(0, 0), a2, voffA);
            PG8_BAR; PG8_WAIT_L(0); PG8_MMA(1, 0, At, B0); PG8_BAR; PG8_SCHED;
            PG8_STAGE(PG8_SB(0, 1), b2 + hstep, voffB);
            PG8_WAIT_V(6); PG8_BAR; PG8_MMA(1, 1, At, B1); PG8_BAR;
            PG8_LDB(B0, 1, 0); PG8_SCHED; PG8_LDA(At, 1, 0); PG8_STAGE(PG8_SA(0, 1), a2 + hstep, voffA);
            PG8_WAIT_L(8); PG8_BAR; PG8_WAIT_L(0); PG8_MMA(0, 0, At, B0); PG8_BAR; PG8_SCHED;
            PG8_LDB(B1, 1, 1); PG8_STAGE(PG8_SB(1, 0), b3, voffB);
            PG8_BAR; PG8_WAIT_L(0); PG8_MMA(0, 1, At, B1); PG8_BAR;
            PG8_LDA(At, 1, 1); PG8_STAGE(PG8_SA(1, 0), a3, voffA);
            PG8_BAR; PG8_WAIT_L(0); PG8_MMA(1, 0, At, B0); PG8_BAR; PG8_SCHED;
            PG8_STAGE(PG8_SB(1, 1), b3 + hstep, voffB);
            PG8_WAIT_V(6); PG8_BAR; PG8_MMA(1, 1, At, B1); PG8_BAR;
            }
        }
        if constexpr (FP8) { asm volatile("s_nop 15\n\ts_nop 15\n\ts_nop 15\n\ts_nop 15" ::: "memory"); }
        if constexpr (ALIGN_EPI) { if (wr == 0) PG8_BAR; }
        if constexpr (!Epi::AFTER_DRAIN) { E(acc, cur, wr, wc, fr, fq); S.done(cur); }
        if (!has_next) break;
#pragma unroll
        for (int a = 0; a < 2; ++a)
#pragma unroll
            for (int b = 0; b < 2; ++b)
#pragma unroll
                for (int m = 0; m < 4; ++m)
#pragma unroll
                    for (int n = 0; n < 2; ++n) acc[a][b][m][n] = (f32x4){0.f, 0.f, 0.f, 0.f};
        cur = nxt; cA = nA; cB = nB; ++ui;
        if constexpr (ALIGN_EPI) { if (wr == 1) PG8_BAR; }
    }
    PG8_WAIT_V(0);
    if constexpr (!ALIGN_EPI) { if (wr == 0) PG8_BAR; }
    PG8_BAR;
    if constexpr (Epi::AFTER_DRAIN) { E.fused(acc, cur, wr, wc, fr, fq, lds, wid, lane); S.done(cur); }
#undef PG8_SA
#undef PG8_SB
#undef PG8_STAGE
#undef PG8_LDA
#undef PG8_LDB
#undef PG8_MMA
#undef PG8_LD32
#undef PG8_H
#undef PG8_WAIT_V
#undef PG8_WAIT_L
#undef PG8_BAR
#undef PG8_SCHED
}
}


constexpr int DM = 2048, SEQ = 16384, NSEQ = 3, HD = 128, DFF = 8192, INW = 11264;
constexpr int C_AQ = 0, C_AK = 1536, C_AV = 3072, C_BQ = 4608, C_BK = 6144, C_BV = 6656, C_GA = 7168, C_GB = 9216;
constexpr float RMS_EPS = 1e-6f;
constexpr float LOG2E = 1.4426950408889634f, LN2 = 0.6931471805599453f;

namespace att {
typedef unsigned short bf16;
constexpr int D = 128, NW = 8, QBLK = 32, KVBLK = 64;
constexpr float SCALE = 0.088388347648318440f;
constexpr float THR = 8.f;
constexpr int SHM_V = KVBLK * D * 2, SHM_K = KVBLK * D * 2, SHM_ATTN = 2 * SHM_V + 2 * SHM_K + NW * 64 * 4;
using bf16x8 = __attribute__((ext_vector_type(8))) short;
using s16x4  = __attribute__((ext_vector_type(4))) short;
using f32x16 = __attribute__((ext_vector_type(16))) float;
using u32x4  = __attribute__((ext_vector_type(4))) unsigned;
#define KSWZ(row, colB) ((row) * 256 + ((colB) ^ (((row) & 7) << 4)))
#define SBAR() __builtin_amdgcn_sched_barrier(0)
__device__ __forceinline__ int crow(int r, int hi) { return (r & 3) + 8 * (r >> 2) + 4 * hi; }
__device__ __forceinline__ unsigned cvtpk(float lo, float hi) { unsigned r; asm volatile("v_cvt_pk_bf16_f32 %0, %1, %2" : "=v"(r) : "v"(lo), "v"(hi)); return r; }
__device__ __forceinline__ bf16x8 ld8(const bf16* p) { return *reinterpret_cast<const bf16x8*>(p); }

__device__ __forceinline__ void partialSM(f32x16& p0, f32x16& p1, float& m_reg, float& mn, float& alpha) {
  constexpr float C = SCALE * 1.4426950408889634f;
  float pmax = p0[0]; for (int r = 1; r < 16; ++r) pmax = fmaxf(pmax, p0[r]); for (int r = 0; r < 16; ++r) pmax = fmaxf(pmax, p1[r]);
  { auto rr = __builtin_amdgcn_permlane32_swap(__float_as_uint(pmax), __float_as_uint(pmax), false, false);
    pmax = fmaxf(__uint_as_float(rr[0]), __uint_as_float(rr[1])); }
  if (__builtin_expect(__all(pmax - m_reg <= THR / SCALE), 1)) { mn = m_reg; alpha = 1.f; }
  else { mn = fmaxf(m_reg, pmax); alpha = __builtin_amdgcn_exp2f((m_reg - mn) * C); m_reg = mn; }
  float mnC = -mn * C;
  for (int r = 0; r < 16; ++r) p0[r] = fmaf(p0[r], C, mnC); for (int r = 0; r < 16; ++r) p1[r] = fmaf(p1[r], C, mnC);
  for (int r = 0; r < 16; ++r) p0[r] = __builtin_amdgcn_exp2f(p0[r]);
}
#define PK4(P, BASE, OUT) do { unsigned a0 = cvtpk(P[BASE + 0], P[BASE + 1]), a1 = cvtpk(P[BASE + 2], P[BASE + 3]);   \
    unsigned b0 = cvtpk(P[BASE + 4], P[BASE + 5]), b1 = cvtpk(P[BASE + 6], P[BASE + 7]);                              \
    auto r0 = __builtin_amdgcn_permlane32_swap(a0, b0, false, false); auto r1 = __builtin_amdgcn_permlane32_swap(a1, b1, false, false); \
    u32x4 w = {r0[0], r1[0], r0[1], r1[1]}; OUT = *reinterpret_cast<bf16x8*>(&w); } while (0)
__device__ __forceinline__ void finishSM(f32x16& p0, f32x16& p1, float alpha, float& l_reg, bf16x8& pa0, bf16x8& pa1, bf16x8& pa2, bf16x8& pa3) {
  for (int r = 0; r < 16; ++r) p1[r] = __builtin_amdgcn_exp2f(p1[r]);
  float ps = 0; for (int r = 0; r < 16; ++r) ps += p0[r]; for (int r = 0; r < 16; ++r) ps += p1[r];
  { auto rr = __builtin_amdgcn_permlane32_swap(__float_as_uint(ps), __float_as_uint(ps), false, false);
    ps = __uint_as_float(rr[0]) + __uint_as_float(rr[1]); }
  l_reg = l_reg * alpha + ps;
  PK4(p0, 0, pa0); PK4(p0, 8, pa1); PK4(p1, 0, pa2); PK4(p1, 8, pa3);
}
__device__ __forceinline__ void qkt(f32x16& p0, f32x16& p1, const bf16* Ks, const bf16x8* qr, int r32, int hi) {
  p0 = f32x16{}; p1 = f32x16{};
  for (int d0 = 0; d0 < 8; ++d0) { int cb = (d0 * 16 + hi * 8) * 2;
    bf16x8 b0 = *reinterpret_cast<const bf16x8*>((const char*)Ks + KSWZ(r32, cb));
    bf16x8 b1 = *reinterpret_cast<const bf16x8*>((const char*)Ks + KSWZ(32 + r32, cb));
    p0 = __builtin_amdgcn_mfma_f32_32x32x16_bf16(b0, qr[d0], p0, 0, 0, 0);
    p1 = __builtin_amdgcn_mfma_f32_32x32x16_bf16(b1, qr[d0], p1, 0, 0, 0); }
}
__device__ __forceinline__ int v_st(int k, int c) { const int kk = (k & ~0xC) | ((k & 4) << 1) | ((k & 8) >> 1); return ((kk >> 3) * 4 + (c >> 5)) * 512 + ((kk & 7) * 32 + (c & 31)) * 2; }
__device__ __forceinline__ int v_rd_base(int lane) { return ((lane & 3) << 3) | (((lane >> 2) & 3) << 6) | (((lane >> 4) & 1) << 5) | (((lane >> 5) & 1) << 8); }
constexpr int v_rd_off(int d0, int ks, int half) { return d0 * 512 + ks * 4096 + half * 2048; }
template <int OFF> __device__ __forceinline__ s16x4 tr_read(int vb) {
  s16x4 r; asm volatile("ds_read_b64_tr_b16 %0, %1 offset:%2" : "=&v"(r) : "v"(vb), "i"(OFF) : "memory"); return r;
}
template <int D0> __device__ __forceinline__ void pv_one(f32x16& od, int vb, bf16x8 pa0, bf16x8 pa1, bf16x8 pa2, bf16x8 pa3) {
  const s16x4 l0 = tr_read<v_rd_off(D0, 0, 0)>(vb), h0 = tr_read<v_rd_off(D0, 0, 1)>(vb), l1 = tr_read<v_rd_off(D0, 1, 0)>(vb), h1 = tr_read<v_rd_off(D0, 1, 1)>(vb);
  const s16x4 l2 = tr_read<v_rd_off(D0, 2, 0)>(vb), h2 = tr_read<v_rd_off(D0, 2, 1)>(vb), l3 = tr_read<v_rd_off(D0, 3, 0)>(vb), h3 = tr_read<v_rd_off(D0, 3, 1)>(vb);
  asm volatile("s_waitcnt lgkmcnt(0)" ::: "memory"); SBAR();
#define PK(L, H) (bf16x8){L[0], L[1], L[2], L[3], H[0], H[1], H[2], H[3]}
  od = __builtin_amdgcn_mfma_f32_32x32x16_bf16(pa0, PK(l0, h0), od, 0, 0, 0);
  od = __builtin_amdgcn_mfma_f32_32x32x16_bf16(pa1, PK(l1, h1), od, 0, 0, 0);
  od = __builtin_amdgcn_mfma_f32_32x32x16_bf16(pa2, PK(l2, h2), od, 0, 0, 0);
  od = __builtin_amdgcn_mfma_f32_32x32x16_bf16(pa3, PK(l3, h3), od, 0, 0, 0);
#undef PK
}
__device__ __forceinline__ void pv_d0(f32x16* o, int vb, bf16x8 pa0, bf16x8 pa1, bf16x8 pa2, bf16x8 pa3) {
  pv_one<0>(o[0], vb, pa0, pa1, pa2, pa3); pv_one<1>(o[1], vb, pa0, pa1, pa2, pa3); pv_one<2>(o[2], vb, pa0, pa1, pa2, pa3); pv_one<3>(o[3], vb, pa0, pa1, pa2, pa3);
}

template <int LDQ, int LDK, int LDO>
__device__ __forceinline__ void attn_dense_body(const bf16* __restrict__ Qb, const bf16* __restrict__ Kh, const bf16* __restrict__ Vh, bf16* __restrict__ Ob, int seq, char* lds) {
  constexpr int SDEPTH = 2;
  const int tid = pg8::otid(), wid = tid >> 6, lane = tid & 63, r32 = lane & 31, hi = lane >> 5;
  bf16* V_lds = (bf16*)lds; bf16* K_lds = (bf16*)(lds + 2 * SHM_V);
  float* ws = (float*)(lds + 2 * SHM_V + 2 * SHM_K) + wid * 64; float* li_l = ws; float* al_l = ws + 32;
  float m_reg = -1e30f, l_reg = 0; f32x16 o[4] = {}; bf16x8 qr[8];
  const bf16* Qw = Qb + (long)(wid * QBLK + r32) * LDQ + hi * 8;
#pragma unroll
  for (int d0 = 0; d0 < 8; ++d0) qr[d0] = ld8(Qw + d0 * 16);
  const int sr = tid >> 4, sc = (tid & 15) * 8, vst0 = v_st(sr, sc), vst1 = v_st(32 + sr, sc);
  const int vb0 = (int)(uintptr_t)V_lds + v_rd_base(lane);
  struct { bf16x8 vs0, vs1, ks0, ks1; } sr_[SDEPTH];
#define SLOAD(i, k0) do { sr_[i].vs0 = ld8(&Vh[(long)((k0) + sr) * LDK + sc]); sr_[i].vs1 = ld8(&Vh[(long)((k0) + 32 + sr) * LDK + sc]); \
    sr_[i].ks0 = ld8(&Kh[(long)((k0) + sr) * LDK + sc]); sr_[i].ks1 = ld8(&Kh[(long)((k0) + 32 + sr) * LDK + sc]); } while (0)
#define SWRITE(b, i) do { *(bf16x8*)((char*)V_lds + (b) * SHM_V + vst0) = sr_[i].vs0;          \
    *(bf16x8*)((char*)V_lds + (b) * SHM_V + vst1) = sr_[i].vs1; int kc = sc * 2;               \
    *(bf16x8*)((char*)K_lds + (b) * SHM_K + KSWZ(sr, kc)) = sr_[i].ks0;                       \
    *(bf16x8*)((char*)K_lds + (b) * SHM_K + KSWZ(32 + sr, kc)) = sr_[i].ks1; } while (0)
#define SWAIT() asm volatile("s_waitcnt vmcnt(4)" ::: "memory")
#define RESC(a) do { if (__any((a) < 1.f)) { if (hi == 0) al_l[r32] = (a); asm volatile("s_waitcnt lgkmcnt(0)" ::: "memory"); \
    for (int d = 0; d < 4; ++d) for (int r = 0; r < 16; ++r) o[d][r] *= al_l[crow(r, hi)]; } } while (0)
  f32x16 pA0, pA1, pB0, pB1; float mnA, mnB, alA, alB; bf16x8 pa0, pa1, pa2, pa3; const int NT = seq / KVBLK;
  constexpr int SE = 0, SO = SDEPTH - 1;
  SLOAD(SE, 0); asm volatile("s_waitcnt vmcnt(0)" ::: "memory"); SWRITE(0, SE); __syncthreads();
  qkt(pA0, pA1, K_lds, qr, r32, hi); partialSM(pA0, pA1, m_reg, mnA, alA);
  SLOAD(SO, KVBLK); if (2 < NT) SLOAD(SE, 2 * KVBLK);
  SWAIT(); SWRITE(1, SO); __syncthreads();
  for (int j = 1; j + 1 < NT; j += 2) {
    SBAR(); qkt(pB0, pB1, (bf16*)((char*)K_lds + SHM_K), qr, r32, hi);
    finishSM(pA0, pA1, alA, l_reg, pa0, pa1, pa2, pa3); SBAR();
    SLOAD(SO, (j + SDEPTH) * KVBLK); SBAR();
    pv_d0(o, vb0, pa0, pa1, pa2, pa3); partialSM(pB0, pB1, m_reg, mnB, alB);
    __syncthreads(); SWAIT(); SWRITE(0, SE);
    RESC(alB); __syncthreads();
    SBAR(); qkt(pA0, pA1, K_lds, qr, r32, hi);
    finishSM(pB0, pB1, alB, l_reg, pa0, pa1, pa2, pa3); SBAR();
    if (j + 3 < NT) SLOAD(SE, (j + 1 + SDEPTH) * KVBLK); SBAR();
    pv_d0(o, vb0 + (int)SHM_V, pa0, pa1, pa2, pa3); partialSM(pA0, pA1, m_reg, mnA, alA);
    __syncthreads(); SWAIT(); SWRITE(1, SO);
    RESC(alA); __syncthreads();
  }
  SBAR(); qkt(pB0, pB1, (bf16*)((char*)K_lds + SHM_K), qr, r32, hi);
  finishSM(pA0, pA1, alA, l_reg, pa0, pa1, pa2, pa3); SBAR();
  pv_d0(o, vb0, pa0, pa1, pa2, pa3); partialSM(pB0, pB1, m_reg, mnB, alB);
  __syncthreads(); RESC(alB);
  finishSM(pB0, pB1, alB, l_reg, pa0, pa1, pa2, pa3); SBAR();
  pv_d0(o, vb0 + (int)SHM_V, pa0, pa1, pa2, pa3);
  if (hi == 0) li_l[r32] = l_reg; asm volatile("s_waitcnt lgkmcnt(0)" ::: "memory");
  float rli[16];
#pragma unroll
  for (int r = 0; r < 16; ++r) rli[r] = __builtin_amdgcn_rcpf(li_l[crow(r, hi)]);
  bf16* Ow = Ob + (long)(wid * QBLK) * LDO;
#pragma unroll
  for (int r = 0; r < 16; ++r) { int orow = crow(r, hi);
#pragma unroll
    for (int d0 = 0; d0 < 4; ++d0) { const float v = o[d0][r] * rli[r]; Ow[(long)orow * LDO + d0 * 32 + r32] = (bf16)(cvtpk(v, v) & 0xffffu); } }
#undef SLOAD
#undef SWRITE
#undef SWAIT
}

__device__ __forceinline__ void dil_unit(const bf16* __restrict__ proj, bf16* __restrict__ og, float* __restrict__ lse, int g, int h, int res, int q0, char* lds) {
  const int d = (g == 0) ? 1 : (g == 1 ? 4 : 16), L = SEQ / d;
  const int tid = pg8::otid(), wid = tid >> 6, lane = tid & 63, r32 = lane & 31, hi = lane >> 5;
  bf16* V_lds = (bf16*)lds; bf16* K_lds = (bf16*)(lds + 2 * SHM_V);
  float* ws = (float*)(lds + 2 * SHM_V + 2 * SHM_K) + wid * 64; float* li_l = ws; float* al_l = ws + 32;
  const int colb = g * 512 + h * 128;
  const float slope = exp2f(-8.0f * (float)(g * 4 + h + 1) / 12.0f);
  const float sl2 = slope * (float)d * LOG2E;
  constexpr float C = SCALE * LOG2E;
  float m_reg = -1e30f, l_reg = 0; f32x16 o[4] = {}; bf16x8 qr[8];
  const int wq0 = q0 + wid * QBLK, qj = wq0 + r32;
  { const bf16* Qw = proj + (size_t)((size_t)qj * d + res) * INW + C_AQ + colb + hi * 8;
#pragma unroll
    for (int d0 = 0; d0 < 8; ++d0) qr[d0] = ld8(Qw + d0 * 16); }
  const int sr = tid >> 4, sc = (tid & 15) * 8, vst0 = v_st(sr, sc), vst1 = v_st(32 + sr, sc);
  const int vb0 = (int)(uintptr_t)V_lds + v_rd_base(lane);
  bf16x8 vs0, vs1, ks0, ks1;
#define DLOAD(kt) do { int ka = q0 - 64 + 64 * (kt) + sr, kb = ka + 32; ka = ka < 0 ? 0 : (ka > L - 1 ? L - 1 : ka); kb = kb < 0 ? 0 : (kb > L - 1 ? L - 1 : kb); \
    const bf16* pa_ = proj + (size_t)((size_t)ka * d + res) * INW + colb + sc; const bf16* pb_ = proj + (size_t)((size_t)kb * d + res) * INW + colb + sc; \
    vs0 = ld8(pa_ + C_AV); vs1 = ld8(pb_ + C_AV); ks0 = ld8(pa_ + C_AK); ks1 = ld8(pb_ + C_AK); } while (0)
#define DWRITE(b) do { *(bf16x8*)((char*)V_lds + (b) * SHM_V + vst0) = vs0; *(bf16x8*)((char*)V_lds + (b) * SHM_V + vst1) = vs1; const int kc = sc * 2; \
    *(bf16x8*)((char*)K_lds + (b) * SHM_K + KSWZ(sr, kc)) = ks0; *(bf16x8*)((char*)K_lds + (b) * SHM_K + KSWZ(32 + sr, kc)) = ks1; } while (0)
  DLOAD(0);
  const int kt_lo = wid >> 1;
  for (int kt = 0; kt < 6; ++kt) {
    const int b = kt & 1;
    asm volatile("s_waitcnt vmcnt(0)" ::: "memory"); DWRITE(b);
    if (kt + 1 < 6) DLOAD(kt + 1);
    __syncthreads();
    if (kt >= kt_lo && kt <= kt_lo + 2) {
      f32x16 p0, p1;
      qkt(p0, p1, (const bf16*)((const char*)K_lds + b * SHM_K), qr, r32, hi);
      const int k0 = q0 - 64 + 64 * kt;
      float pmax = -INFINITY;
#pragma unroll
      for (int r = 0; r < 16; ++r) {
        const int kj0 = k0 + crow(r, hi), kj1 = kj0 + 32; const int a0 = abs(kj0 - qj), a1 = abs(kj1 - qj);
        const bool v0 = (a0 <= 64) && (kj0 >= 0) && (kj0 < L), v1 = (a1 <= 64) && (kj1 >= 0) && (kj1 < L);
        p0[r] = v0 ? fmaf(p0[r], C, -sl2 * (float)a0) : -INFINITY; p1[r] = v1 ? fmaf(p1[r], C, -sl2 * (float)a1) : -INFINITY;
        pmax = fmaxf(pmax, fmaxf(p0[r], p1[r])); }
      { auto rr = __builtin_amdgcn_permlane32_swap(__float_as_uint(pmax), __float_as_uint(pmax), false, false);
        pmax = fmaxf(__uint_as_float(rr[0]), __uint_as_float(rr[1])); }
      const float mn = fmaxf(m_reg, pmax); const float alpha = __builtin_amdgcn_exp2f(m_reg - mn); m_reg = mn;
      float ps = 0.f;
#pragma unroll
      for (int r = 0; r < 16; ++r) { p0[r] = __builtin_amdgcn_exp2f(p0[r] - mn); p1[r] = __builtin_amdgcn_exp2f(p1[r] - mn); ps += p0[r] + p1[r]; }
      { auto rr = __builtin_amdgcn_permlane32_swap(__float_as_uint(ps), __float_as_uint(ps), false, false);
        ps = __uint_as_float(rr[0]) + __uint_as_float(rr[1]); }
      l_reg = l_reg * alpha + ps;
      RESC(alpha);
      bf16x8 pa0, pa1, pa2, pa3;
      PK4(p0, 0, pa0); PK4(p0, 8, pa1); PK4(p1, 0, pa2); PK4(p1, 8, pa3);
      pv_d0(o, vb0 + b * (int)SHM_V, pa0, pa1, pa2, pa3);
    }
  }
  if (hi == 0) { li_l[r32] = l_reg; lse[(size_t)((size_t)qj * d + res) * 12 + g * 4 + h] = (m_reg + __log2f(l_reg)) * LN2; }
  asm volatile("s_waitcnt lgkmcnt(0)" ::: "memory");
  const bool odd = (r32 & 1) != 0;
#pragma unroll
  for (int rp = 0; rp < 16; rp += 2) { const float rle = __builtin_amdgcn_rcpf(li_l[crow(rp, hi)]), rlo = __builtin_amdgcn_rcpf(li_l[crow(rp + 1, hi)]);
    const int orow = crow(rp + (odd ? 1 : 0), hi);
    unsigned* Ow = (unsigned*)(og + (size_t)((size_t)(wq0 + orow) * d + res) * 1536 + colb + (r32 & ~1));
#pragma unroll
    for (int d0 = 0; d0 < 4; ++d0) { const float ve = o[d0][rp] * rle, vo = o[d0][rp + 1] * rlo;
      const float mine = odd ? vo : ve, give = odd ? ve : vo;
      const float got = __uint_as_float(__builtin_amdgcn_mov_dpp(__float_as_uint(give), 0xB1, 0xF, 0xF, true));
      Ow[d0 * 16] = odd ? cvtpk(got, mine) : cvtpk(mine, got); } }
  __syncthreads();
#undef DLOAD
#undef DWRITE
}
#undef RESC
#undef PK4
#undef KSWZ
#undef SBAR
}


namespace att8 {
typedef int v8i __attribute__((ext_vector_type(8)));
typedef int v4i __attribute__((ext_vector_type(4)));
using att::f32x16; using att::crow;
constexpr int TILE_B = 8192, NSLOT = 4;
constexpr int LDS_K = 0, LDS_V = NSLOT * TILE_B, LDS_WS = 2 * NSLOT * TILE_B, LDS_BYTES8 = LDS_WS + 8 * 256;
constexpr float THR2 = 5.0f;
constexpr float PSH = 3.0f;
constexpr int SC_ONE = 0, SC_Q = 0;
#define A8_LAS __attribute__((address_space(3)))
#define A8_WAIT_V(n) asm volatile("s_waitcnt vmcnt(" #n ")" ::: "memory")
#define A8_BAR() do { asm volatile("" ::: "memory"); __builtin_amdgcn_s_barrier(); asm volatile("" ::: "memory"); } while (0)
__device__ __forceinline__ v8i ld32(const A8_LAS unsigned char* p0, const A8_LAS unsigned char* p1) {
  const v4i a = *(const A8_LAS v4i*)p0, b = *(const A8_LAS v4i*)p1; return (v8i){a[0], a[1], a[2], a[3], b[0], b[1], b[2], b[3]};
}
__device__ __forceinline__ float max3f(float a, float b, float c) { return fmaxf(fmaxf(a, b), c); }
__device__ __forceinline__ void qkt8(f32x16& p0, f32x16& p1, const A8_LAS unsigned char* ks, const int (&koff)[4], const v8i (&qf)[2]) {
  p0 = f32x16{}; p1 = f32x16{};
#pragma unroll
  for (int kk = 0; kk < 2; ++kk) {
    const v8i a0 = ld32(ks + koff[2 * kk], ks + koff[2 * kk + 1]), a1 = ld32(ks + 4096 + koff[2 * kk], ks + 4096 + koff[2 * kk + 1]);
    p0 = __builtin_amdgcn_mfma_scale_f32_32x32x64_f8f6f4(a0, qf[kk], p0, 0, 0, 0, SC_ONE, 0, SC_Q);
    p1 = __builtin_amdgcn_mfma_scale_f32_32x32x64_f8f6f4(a1, qf[kk], p1, 0, 0, 0, SC_ONE, 0, SC_Q); }
}
__device__ __forceinline__ void partialSM8(f32x16& p0, f32x16& p1, float& m_reg, float& alpha, float& sc) {
  float pmax = max3f(p0[0], p0[1], p0[2]);
#pragma unroll
  for (int r = 3; r < 15; r += 2) pmax = max3f(pmax, p0[r], p0[r + 1]);
  pmax = fmaxf(pmax, p0[15]);
#pragma unroll
  for (int r = 0; r < 16; r += 2) pmax = max3f(pmax, p1[r], p1[r + 1]);
  { auto rr = __builtin_amdgcn_permlane32_swap(__float_as_uint(pmax), __float_as_uint(pmax), false, false);
    pmax = fmaxf(__uint_as_float(rr[0]), __uint_as_float(rr[1])); }
  alpha = 1.f;
  if (__builtin_expect(!__all(pmax - m_reg <= THR2), 0)) { const float mn = fmaxf(m_reg, __builtin_ceilf(pmax)); alpha = __builtin_amdgcn_exp2f(m_reg - mn); m_reg = mn; }
  sc = __builtin_amdgcn_exp2f(m_reg - PSH);
#pragma unroll
  for (int r = 0; r < 16; ++r) p0[r] = __builtin_amdgcn_exp2f(p0[r]);
}
typedef short v2s __attribute__((ext_vector_type(2)));
__device__ __forceinline__ int pk4_fp8(float a, float b, float c, float d, float sc) {
  v2s x = __builtin_amdgcn_cvt_scalef32_pk_fp8_f32((v2s){0, 0}, a, b, sc, false); x = __builtin_amdgcn_cvt_scalef32_pk_fp8_f32(x, c, d, sc, true); return __builtin_bit_cast(int, x);
}
__device__ __forceinline__ void finishSM8(const f32x16& p0, f32x16& p1, float sc, v8i& pf) {
#pragma unroll
  for (int r = 0; r < 16; ++r) p1[r] = __builtin_amdgcn_exp2f(p1[r]);
#pragma unroll
  for (int w = 0; w < 4; ++w) pf[w] = pk4_fp8(p0[4 * w], p0[4 * w + 1], p0[4 * w + 2], p0[4 * w + 3], sc);
#pragma unroll
  for (int w = 0; w < 4; ++w) pf[4 + w] = pk4_fp8(p1[4 * w], p1[4 * w + 1], p1[4 * w + 2], p1[4 * w + 3], sc);
}
typedef float f32x4_t __attribute__((ext_vector_type(4)));
#define A8_ROWSUM(ls, pf, bp) ls = __builtin_amdgcn_mfma_scale_f32_16x16x128_f8f6f4(pf, bp, ls, 0, 0, 0, 0, 0, 0)
__device__ __forceinline__ void pv8(f32x16 (&o)[4], f32x4_t& lsum, const v8i& bpat, const A8_LAS unsigned char* vs, const int (&voff)[2], const v8i& pf) {
#pragma unroll
  for (int d0 = 0; d0 < 4; ++d0) { const v8i b = ld32(vs + d0 * 2048 + voff[0], vs + d0 * 2048 + voff[1]);
    o[d0] = __builtin_amdgcn_mfma_scale_f32_32x32x64_f8f6f4(pf, b, o[d0], 0, 0, 0, SC_ONE, 0, SC_ONE); }
  A8_ROWSUM(lsum, pf, bpat);
}
constexpr int RING8 = 8, LDS_V8 = RING8 * TILE_B, LDS_WS8 = 2 * RING8 * TILE_B + 1024;
__device__ __forceinline__ void softmax8p(f32x16& p0, f32x16& p1, float& m_reg, float& alpha, v8i& pf) {
  float pmax = max3f(p0[0], p0[1], p0[2]);
#pragma unroll
  for (int r = 3; r < 15; r += 2) pmax = max3f(pmax, p0[r], p0[r + 1]);
  pmax = fmaxf(pmax, p0[15]);
#pragma unroll
  for (int r = 0; r < 16; r += 2) pmax = max3f(pmax, p1[r], p1[r + 1]);
  { auto rr = __builtin_amdgcn_permlane32_swap(__float_as_uint(pmax), __float_as_uint(pmax), false, false);
    pmax = fmaxf(__uint_as_float(rr[0]), __uint_as_float(rr[1])); }
  const bool grow = !__all(pmax - m_reg <= THR2);
  const float mn = grow ? fmaxf(m_reg, __builtin_ceilf(pmax)) : m_reg;
  alpha = __builtin_amdgcn_exp2f(m_reg - mn); m_reg = mn;
  const float sc = __builtin_amdgcn_exp2f(m_reg - PSH);
#pragma unroll
  for (int r = 0; r < 16; ++r) { p0[r] = __builtin_amdgcn_exp2f(p0[r]); p1[r] = __builtin_amdgcn_exp2f(p1[r]); }
#pragma unroll
  for (int w = 0; w < 4; ++w) pf[w] = pk4_fp8(p0[4 * w], p0[4 * w + 1], p0[4 * w + 2], p0[4 * w + 3], sc);
#pragma unroll
  for (int w = 0; w < 4; ++w) pf[4 + w] = pk4_fp8(p1[4 * w], p1[4 * w + 1], p1[4 * w + 2], p1[4 * w + 3], sc);
}
template <int LDQ8, int LDO>
__device__ __forceinline__ void attn8_body(const unsigned char* __restrict__ Q8b, const unsigned char* __restrict__ Kimg, const unsigned char* __restrict__ Vimg,
                                           unsigned char* __restrict__ Ob, int NT, A8_LAS unsigned char* lds) {
  const int tid = pg8::otid(), wid = __builtin_amdgcn_readfirstlane(tid >> 6), lane = tid & 63, r32 = lane & 31, hi = lane >> 5;
  A8_LAS float* al_l = (A8_LAS float*)(lds + LDS_WS8) + wid * 64;
  v8i qf[2];
  { const unsigned char* qp = Q8b + (size_t)(wid * 32 + r32) * LDQ8 + 32 * hi;
#pragma unroll
    for (int kk = 0; kk < 2; ++kk) { const v4i a = *(const v4i*)(qp + 64 * kk), b = *(const v4i*)(qp + 64 * kk + 16); qf[kk] = (v8i){a[0], a[1], a[2], a[3], b[0], b[1], b[2], b[3]}; } }
  int koff[4], voff[2];
  { const int sK = (r32 >> 1) & 7, sV = (r32 >> 2) & 3;
#pragma unroll
    for (int kk = 0; kk < 2; ++kk)
#pragma unroll
      for (int e = 0; e < 2; ++e) koff[2 * kk + e] = r32 * 128 + (((4 * kk + 2 * hi + e) ^ sK) << 4);
#pragma unroll
    for (int e = 0; e < 2; ++e) voff[e] = LDS_V8 + r32 * 64 + (((2 * hi + e) ^ sV) << 4); }
  const unsigned goff = (unsigned)wid * 1024u + (unsigned)lane * 16u;
  A8_LAS unsigned char* kdst = lds + wid * 1024; A8_LAS unsigned char* vdst = lds + LDS_V8 + wid * 1024;
#define A8_STAGE(t) do { const int t_ = (t) < NT ? (t) : NT - 1; const int sl_ = ((t) & 7) * TILE_B; \
    __builtin_amdgcn_global_load_lds((const unsigned*)(Kimg + (size_t)t_ * TILE_B + goff), (A8_LAS unsigned*)(kdst + sl_), 16, 0, 0); \
    __builtin_amdgcn_global_load_lds((const unsigned*)(Vimg + (size_t)t_ * TILE_B + goff), (A8_LAS unsigned*)(vdst + sl_), 16, 0, 0); } while (0)
#define A8_RESC(a) do { if (__any((a) < 1.f)) { if (hi == 0) al_l[r32] = (a); asm volatile("s_waitcnt lgkmcnt(0)" ::: "memory"); \
    _Pragma("unroll") for (int r = 0; r < 16; ++r) { const float f_ = al_l[crow(r, hi)]; _Pragma("unroll") for (int d = 0; d < 4; ++d) o[d][r] *= f_; } \
    _Pragma("unroll") for (int i = 0; i < 4; ++i) lsum[i] *= al_l[lrow0 + i]; } } while (0)
#define A8_KS(t) (lds + ((t) & 7) * TILE_B)
#define A8_VS(t) (lds + ((t) & 7) * TILE_B)
#define A8_SYNC(t) do { A8_WAIT_V(2); A8_BAR(); } while (0)
  f32x16 o[4] = {}; float m_reg = -1e30f, alpha; f32x4_t lsum = {0.f, 0.f, 0.f, 0.f};
  f32x16 pA0, pA1, pB0, pB1; v8i pfA, pfB = {}, kf[4], vf[4], bpat;
  const int lrow0 = 4 * (lane >> 4) + (((lane & 15) >= 8) ? 16 : 0);
  { const int bv = ((((lane >> 4) & 1) != 0) == ((lane & 15) >= 8)) ? 0x38383838 : 0;
    bpat = (v8i){bv, bv, bv, bv, bv, bv, bv, bv}; asm volatile("" : "+v"(bpat)); }
#define A8_SB() __builtin_amdgcn_sched_barrier(0)
#define A8_MFA(acc, A, B, sb) acc = __builtin_amdgcn_mfma_scale_f32_32x32x64_f8f6f4(A, B, acc, 0, 0, 0, SC_ONE, 0, sb)
#define A8_KLOAD(t) do { kf[0] = ld32(A8_KS(t) + koff[0], A8_KS(t) + koff[1]); kf[1] = ld32(A8_KS(t) + 4096 + koff[0], A8_KS(t) + 4096 + koff[1]); \
    kf[2] = ld32(A8_KS(t) + koff[2], A8_KS(t) + koff[3]); kf[3] = ld32(A8_KS(t) + 4096 + koff[2], A8_KS(t) + 4096 + koff[3]); } while (0)
#define A8_VLOAD(t) do { _Pragma("unroll") for (int d0 = 0; d0 < 2; ++d0) vf[d0] = ld32(A8_VS(t) + d0 * 2048 + voff[0], A8_VS(t) + d0 * 2048 + voff[1]); } while (0)
#define A8_VLOAD2(t) do { _Pragma("unroll") for (int d0 = 2; d0 < 4; ++d0) vf[d0] = ld32(A8_VS(t) + d0 * 2048 + voff[0], A8_VS(t) + d0 * 2048 + voff[1]); } while (0)
#define A8_EXPS(P, M, lo, hi_) do { _Pragma("unroll") for (int r = (lo); r < (hi_); r += 2) { P[r] = __builtin_amdgcn_exp2f(P[r]); P[r + 1] = __builtin_amdgcn_exp2f(P[r + 1]); M = max3f(M, P[r], P[r + 1]); } asm volatile("" : "+v"(M)); } while (0)
#define A8_EXPS0(P, M, lo, hi_) do { P[lo] = __builtin_amdgcn_exp2f(P[lo]); P[(lo) + 1] = __builtin_amdgcn_exp2f(P[(lo) + 1]); M = fmaxf(P[lo], P[(lo) + 1]); A8_EXPS(P, M, (lo) + 2, hi_); } while (0)
#define A8_PIN(x) asm volatile("" : "+v"(x))
#define A8_PK(w, P, i) do { v2s x_; asm volatile("" : "=v"(x_));   x_ = __builtin_amdgcn_cvt_scalef32_pk_fp8_f32(x_, P[i], P[i + 1], sc, false); x_ = __builtin_amdgcn_cvt_scalef32_pk_fp8_f32(x_, P[i + 2], P[i + 3], sc, true); pfN_[w] = __builtin_bit_cast(int, x_); } while (0)
#define A8_STEP(tk, tv_next, pN0, pN1, pO0, pO1, pfN, pfO) do { v8i& pfN_ = pfN; float pm_; \
    A8_SB(); A8_MFA(o[0], pfO, vf[0], SC_ONE); A8_PIN(o[0]); A8_SB(); \
    A8_VLOAD2((tk) - 2); A8_SB(); A8_EXPS0(pO0, pm_, 0, 4); A8_SB(); \
    A8_MFA(o[1], pfO, vf[1], SC_ONE); A8_PIN(o[1]); A8_SB(); \
    A8_EXPS(pO0, pm_, 4, 10); A8_SB(); \
    A8_MFA(o[2], pfO, vf[2], SC_ONE); A8_PIN(o[2]); A8_SB(); \
    A8_KLOAD(tk); A8_SB(); A8_EXPS(pO0, pm_, 10, 12); A8_SB(); \
    A8_MFA(o[3], pfO, vf[3], SC_ONE); A8_PIN(o[3]); A8_SB(); \
    A8_EXPS(pO0, pm_, 12, 16); A8_SB(); \
    A8_ROWSUM(lsum, pfO, bpat); A8_PIN(lsum); A8_SB(); \
    A8_EXPS(pO1, pm_, 0, 2); A8_SB(); \
    { const f32x16 z_ = {}; pN0 = __builtin_amdgcn_mfma_scale_f32_32x32x64_f8f6f4(kf[0], qf[0], z_, 0, 0, 0, SC_ONE, 0, SC_Q); } A8_PIN(pN0); A8_SB(); \
    A8_STAGE((tk) + 2); A8_SB(); A8_EXPS(pO1, pm_, 2, 4); A8_SB(); \
    { const f32x16 z_ = {}; pN1 = __builtin_amdgcn_mfma_scale_f32_32x32x64_f8f6f4(kf[1], qf[0], z_, 0, 0, 0, SC_ONE, 0, SC_Q); } A8_PIN(pN1); A8_SB(); \
    A8_EXPS(pO1, pm_, 4, 10); A8_SB(); \
    A8_MFA(pN0, kf[2], qf[1], SC_Q); A8_PIN(pN0); A8_SB(); \
    A8_EXPS(pO1, pm_, 10, 16); A8_SB(); \
    A8_MFA(pN1, kf[3], qf[1], SC_Q); A8_PIN(pN1); A8_SB(); \
    if (__builtin_expect(!__all(pm_ <= bound), 0)) { \
      float rm_; { auto rr_ = __builtin_amdgcn_permlane32_swap(__float_as_uint(pm_), __float_as_uint(pm_), false, false); rm_ = fmaxf(__uint_as_float(rr_[0]), __uint_as_float(rr_[1])); } \
      const float mn_ = fmaxf(m_reg, __builtin_ceilf(__builtin_amdgcn_logf(rm_))); const float alpha_ = __builtin_amdgcn_exp2f(m_reg - mn_); m_reg = mn_; \
      sc = __builtin_amdgcn_exp2f(m_reg - PSH); bound = __builtin_amdgcn_exp2f(m_reg + 5.0f); A8_RESC(alpha_); } \
    A8_PK(0, pO0, 0); A8_PK(1, pO0, 4); A8_PK(2, pO0, 8); A8_PK(3, pO0, 12); A8_PK(4, pO1, 0); A8_PK(5, pO1, 4); A8_PK(6, pO1, 8); A8_PK(7, pO1, 12); A8_PIN(pfN_); \
    A8_VLOAD(tv_next); A8_SB(); } while (0)
  asm volatile("s_waitcnt vmcnt(0)" ::: "memory");
  A8_STAGE(0); A8_STAGE(1);
  A8_SYNC(0); A8_STAGE(2); qkt8(pA0, pA1, A8_KS(0), koff, qf);
  A8_SYNC(1); A8_STAGE(3); qkt8(pB0, pB1, A8_KS(1), koff, qf); softmax8p(pA0, pA1, m_reg, alpha, pfA); A8_VLOAD(0);
  float sc = __builtin_amdgcn_exp2f(m_reg - PSH), bound = __builtin_amdgcn_exp2f(m_reg + 5.0f);
  int j = 2;
  for (int jb = 0; jb < (NT - 2) / 8; ++jb) { j = 2 + 8 * jb;
#define A8_PAIR(i) A8_SYNC(j + (i)); A8_STEP(j + (i), j + (i) - 1, pA0, pA1, pB0, pB1, pfB, pfA); A8_SYNC(j + (i) + 1); A8_STEP(j + (i) + 1, j + (i), pB0, pB1, pA0, pA1, pfA, pfB)
    A8_PAIR(0); A8_PAIR(2); A8_PAIR(4); A8_PAIR(6);
  }
  for (j = 2 + 8 * ((NT - 2) / 8); j + 1 < NT; j += 2) { A8_PAIR(0); }
#undef A8_PAIR
  softmax8p(pB0, pB1, m_reg, alpha, pfB); pv8(o, lsum, bpat, A8_VS(NT - 2), voff, pfA);
  A8_RESC(alpha);
  pv8(o, lsum, bpat, A8_VS(NT - 1), voff, pfB);
#undef A8_STEP
#undef A8_EXPS
#undef A8_EXPS0
#undef A8_PIN
#undef A8_PK
#undef A8_KLOAD
#undef A8_VLOAD
#undef A8_VLOAD2
#undef A8_MFA
#undef A8_SB
  if ((lane & 7) == 0) {
#pragma unroll
    for (int i = 0; i < 4; ++i) al_l[lrow0 + i] = __builtin_amdgcn_rcpf(lsum[i]) * 64.f; }
  asm volatile("s_waitcnt lgkmcnt(0)" ::: "memory");
  unsigned char* Ow = Ob + (size_t)(wid * 32) * LDO;
#pragma unroll
  for (int r = 0; r < 16; ++r) { const int orow = crow(r, hi); const float rl = al_l[orow];
#pragma unroll
    for (int d0 = 0; d0 < 4; ++d0) { const float v = o[d0][r] * rl; Ow[(size_t)orow * LDO + d0 * 32 + r32] = (unsigned char)(__builtin_amdgcn_cvt_pk_fp8_f32(v, v, 0, false) & 0xff); } }
  A8_WAIT_V(0); A8_BAR();
#undef A8_STAGE
#undef A8_RESC
#undef A8_KS
#undef A8_VS
#undef A8_SYNC
}
}

#ifndef WGM_B
#define WGM_B 4
#endif
#ifndef WGM_E
#define WGM_E 4
#endif
#ifndef WGM_F
#define WGM_F 4
#endif
#ifndef WGM_H
#define WGM_H 4
#endif
#ifndef WGM_I
#define WGM_I 4
#endif
constexpr int NWAVES = 8;
constexpr int N_PHASES = 23;
constexpr size_t MiB = 1u << 20;
constexpr size_t WS_CTL = 0, CTL_ZERO_BYTES = 1 * MiB;
constexpr size_t WS_ROPE = 1 * MiB;
constexpr size_t WS_WIN = 2 * MiB;
constexpr size_t WS_WBR = WS_WIN + 44 * MiB;
constexpr size_t WS_WOUT = WS_WBR + 8 * MiB;
constexpr size_t WS_WFF1 = WS_WOUT + 8 * MiB;
constexpr size_t WS_WFF2 = WS_WFF1 + 32 * MiB;
constexpr size_t WS_HB = WS_WFF2 + 32 * MiB;
constexpr size_t WS_PROJ = WS_HB + 64 * MiB;
constexpr size_t WS_Q8 = WS_PROJ + 352 * MiB;
constexpr size_t WS_K8 = WS_Q8 + 24 * MiB;
constexpr size_t WS_V8 = WS_K8 + 8 * MiB;
constexpr size_t WS_OG = WS_V8 + 8 * MiB;
constexpr size_t WS_LSE = WS_OG + 96 * MiB;
constexpr size_t WS_Y = WS_LSE + 1 * MiB;
constexpr size_t WS_HB8 = WS_Y + 64 * MiB;
constexpr size_t WS_WIN8 = WS_HB8 + 32 * MiB;
constexpr size_t WS_WOUT8 = WS_WIN8 + 12 * MiB;
constexpr size_t WS_WBR8 = WS_WOUT8 + 4 * MiB;
constexpr size_t WS_END = WS_WBR8 + 4 * MiB;
constexpr int N_IN_BF16 = 0;
constexpr int CW_BAR = 4096;
constexpr size_t WS_SS2 = 512 * 1024;
constexpr size_t WS_SS = 256 * 1024;

constexpr int RING_OFF = 0, RING_BYTES = 131072;
constexpr int LDSCTL_OFF = RING_BYTES, MISC_OFF = LDSCTL_OFF + 320;
constexpr int LDS_BYTES = 147456;

#define GAS __attribute__((address_space(1)))
#define LAS __attribute__((address_space(3)))
typedef unsigned short bf16;
typedef unsigned v4u __attribute__((ext_vector_type(4)));
typedef float f32x4 __attribute__((ext_vector_type(4)));
typedef short bf16x8 __attribute__((ext_vector_type(8)));
typedef GAS unsigned gu32;
typedef GAS unsigned long long gu64;
#define RLX_AGENT __ATOMIC_RELAXED, __HIP_MEMORY_SCOPE_AGENT
#define LDS_WAIT() asm volatile("s_waitcnt lgkmcnt(0)" ::: "memory")
#define VM_WAIT() asm volatile("s_waitcnt vmcnt(0)" ::: "memory")
__device__ __forceinline__ unsigned long long rt() { return __builtin_amdgcn_s_memrealtime(); }
__device__ __forceinline__ unsigned f2bf(float f) { unsigned u = __builtin_bit_cast(unsigned, f); return (u + 0x7fffu + ((u >> 16) & 1u)) >> 16; }
__device__ __forceinline__ unsigned pk2(float lo, float hi) { return f2bf(lo) | (f2bf(hi) << 16); }

#define XB_TMO      128
#define XB_XCNT(j)  (256  + 64 * (j))
#define XB_XSUB(j)  (1280 + 64 * (j))
#define XB_XGEN(j)  (2304 + 64 * (j))
#define XB_TOP      3328
#define XB_TOPGEN   3392
#define XCD_BAR_WORDS 3456
#define XB_SPIN_CAP (1u << 18)

__device__ __forceinline__ unsigned xb_ld(unsigned* p)              { return __hip_atomic_load(p, __ATOMIC_RELAXED, __HIP_MEMORY_SCOPE_AGENT); }
__device__ __forceinline__ unsigned xb_add(unsigned* p, unsigned v) { return __hip_atomic_fetch_add(p, v, __ATOMIC_RELAXED, __HIP_MEMORY_SCOPE_AGENT); }
__device__ __forceinline__ unsigned xb_xcc_id() { return (unsigned)__builtin_amdgcn_s_getreg((3 << 11) | 20) & 0xFu; }
#define XB_SPIN(cond, bar) do { unsigned _sp = 0; while (cond) { __builtin_amdgcn_s_sleep(1); \
    if ((++_sp & 255u) == 0u) { if (xb_ld(&(bar)[XB_TMO])) break; if (_sp > XB_SPIN_CAP) { atomicAdd(&(bar)[XB_TMO], 1u); break; } } } } while (0)

struct XcdBarrier {
    unsigned* bar; unsigned x;
    volatile LAS unsigned* st;
};

__device__ __forceinline__ XcdBarrier xcd_barrier_post(unsigned* bar, volatile LAS unsigned* st) {
    XcdBarrier b; b.bar = bar; b.x = xb_xcc_id(); b.st = st;
    if (threadIdx.x == 0) (void)xb_add(&bar[XB_XCNT(b.x)], 1u);
    return b;
}
__device__ __forceinline__ void xcd_barrier_complete(unsigned* bar, unsigned x, unsigned& nloc, unsigned& nx) {
    const unsigned G = gridDim.x * gridDim.y * gridDim.z;
    unsigned sum, cnt, mine, sp = 0u;
    for (;;) {
        sum = 0u; cnt = 0u; mine = 0u;
#pragma unroll
        for (unsigned j = 0; j < 16; ++j) { const unsigned c = xb_ld(&bar[XB_XCNT(j)]); sum += c; cnt += (c > 0u) ? 1u : 0u; mine = (j == x) ? c : mine; }
        if (sum == G) break;
        __builtin_amdgcn_s_sleep(1);
        if ((++sp & 255u) == 0u) { if (xb_ld(&bar[XB_TMO])) break; if (sp > XB_SPIN_CAP) { atomicAdd(&bar[XB_TMO], 1u); break; } }
    }
    nloc = mine > 0u ? mine : 1u; nx = cnt > 0u ? cnt : 1u;
}

__device__ __forceinline__ void xcd_barrier(const XcdBarrier& b) {
    asm volatile("s_waitcnt vmcnt(0)" ::: "memory");
    __syncthreads();
    if (threadIdx.x == 0) {
        unsigned* bar = b.bar;
        __builtin_amdgcn_s_waitcnt(0);
        unsigned nloc = b.st[0], nx = b.st[1];
        if (nloc == 0u) { xcd_barrier_complete(bar, b.x, nloc, nx); b.st[0] = nloc; b.st[1] = nx; }
        const unsigned old = xb_add(&bar[XB_XSUB(b.x)], 1u);
        const unsigned gen = old / nloc;
        if (old + 1u == (gen + 1u) * nloc) {
            __builtin_amdgcn_fence(__ATOMIC_RELEASE, "agent");
            asm volatile("s_waitcnt vmcnt(0)" ::: "memory");
            const unsigned og = xb_add(&bar[XB_TOP], 1u);
            const unsigned tg = og / nx;
            if (og + 1u == (tg + 1u) * nx) xb_add(&bar[XB_TOPGEN], 1u);
            else XB_SPIN(xb_ld(&bar[XB_TOPGEN]) == tg, bar);
            __builtin_amdgcn_fence(__ATOMIC_ACQUIRE, "agent");
            xb_add(&bar[XB_XGEN(b.x)], 1u);
            asm volatile("s_waitcnt vmcnt(0)" ::: "memory");
        } else {
            XB_SPIN(xb_ld(&bar[XB_XGEN(b.x)]) == gen, bar);
            __builtin_amdgcn_fence(__ATOMIC_ACQUIRE, "agent");
            asm volatile("s_waitcnt vmcnt(0)" ::: "memory");
        }
    }
    __syncthreads();
}


__device__ __forceinline__ float wave_sum(float v) {
#pragma unroll
    for (int o = 1; o < 64; o <<= 1) v += __shfl_xor(v, o);
    return v;
}
template <bool GK>
__device__ __forceinline__ void p0_transpose_item(const float* W, int K, int N, bf16* WT, const float* gk, LAS float* scr, int item, int lane) {
    const int nblk = N / 32, kb = item / nblk, nb = item % nblk, k0 = 64 * kb, n0 = 32 * nb;
    float w[32];
#pragma unroll
    for (int i = 0; i < 32; ++i) w[i] = W[(size_t)(k0 + 2 * i + (lane >> 5)) * N + n0 + (lane & 31)];
    const int c = lane & 7;
    f32x4 g0 = {1.f, 1.f, 1.f, 1.f}, g1 = g0;
    if constexpr (GK) { g0 = *(const GAS f32x4*)(gk + k0 + 8 * c); g1 = *(const GAS f32x4*)(gk + k0 + 8 * c + 4); }
    __builtin_amdgcn_sched_barrier(0);
#pragma unroll
    for (int i = 0; i < 32; ++i) scr[(2 * i + (lane >> 5)) * 33 + (lane & 31)] = w[i];
    LDS_WAIT(); asm volatile("" ::: "memory");
#pragma unroll
    for (int j = 0; j < 4; ++j) { const int n = (lane >> 3) + 8 * j; const LAS float* s = scr + (8 * c) * 33 + n;
        v4u o; o.x = pk2(s[0 * 33] * g0.x, s[1 * 33] * g0.y); o.y = pk2(s[2 * 33] * g0.z, s[3 * 33] * g0.w); o.z = pk2(s[4 * 33] * g1.x, s[5 * 33] * g1.y); o.w = pk2(s[6 * 33] * g1.z, s[7 * 33] * g1.w);
        *(GAS v4u*)(WT + (size_t)(n0 + n) * K + k0 + 8 * c) = o; }
    LDS_WAIT(); asm volatile("" ::: "memory");
}
__device__ __forceinline__ unsigned pk4f8(float a, float b, float c, float d) { int x = 0; x = __builtin_amdgcn_cvt_pk_fp8_f32(a, b, x, false); x = __builtin_amdgcn_cvt_pk_fp8_f32(c, d, x, true); return (unsigned)x; }
__device__ __forceinline__ void p0_transpose_item_fp8(const float* W, int K, int N, unsigned char* WT8, int nbase, float wmul, LAS float* scr, int item, int lane, int gate0 = 1 << 30) {
    const int nblk = N / 32, kb = item / nblk, nb = item % nblk, k0 = 64 * kb, n0 = 32 * nb;
    int on0 = n0; if (n0 >= gate0) { const int gq = n0 - gate0, isb = gq >= 2048 ? 1 : 0, jq = gq - 2048 * isb; on0 = gate0 + (jq >> 7) * 256 + isb * 128 + (jq & 127); }
    float w[32];
#pragma unroll
    for (int i = 0; i < 32; ++i) w[i] = W[(size_t)(k0 + 2 * i + (lane >> 5)) * N + n0 + (lane & 31)];
    __builtin_amdgcn_sched_barrier(0);
#pragma unroll
    for (int i = 0; i < 32; ++i) scr[(2 * i + (lane >> 5)) * 33 + (lane & 31)] = w[i] * wmul;
    LDS_WAIT(); asm volatile("" ::: "memory");
    const int c = lane & 3;
#pragma unroll
    for (int j = 0; j < 2; ++j) { const int n = (lane >> 2) + 16 * j; const LAS float* s = scr + (16 * c) * 33 + n;
        v4u o; o.x = pk4f8(s[0 * 33], s[1 * 33], s[2 * 33], s[3 * 33]); o.y = pk4f8(s[4 * 33], s[5 * 33], s[6 * 33], s[7 * 33]);
        o.z = pk4f8(s[8 * 33], s[9 * 33], s[10 * 33], s[11 * 33]); o.w = pk4f8(s[12 * 33], s[13 * 33], s[14 * 33], s[15 * 33]);
        *(GAS v4u*)(WT8 + (size_t)(on0 - nbase + n) * K + k0 + 16 * c) = o; }
    LDS_WAIT(); asm volatile("" ::: "memory");
}
__device__ __forceinline__ void rms_row_to_bf16(const float* xrow, const float* g, bf16* orow, unsigned char* orow8, int lane) {
    const GAS f32x4* xr = (const GAS f32x4*)xrow + lane; const GAS f32x4* gr = (const GAS f32x4*)g + lane;
    f32x4 v[8]; float s = 0.f;
#pragma unroll
    for (int j = 0; j < 8; ++j) { v[j] = xr[64 * j]; s += (v[j].x * v[j].x + v[j].y * v[j].y) + (v[j].z * v[j].z + v[j].w * v[j].w); }
    const float r = 1.0f / sqrtf(wave_sum(s) * (1.f / DM) + RMS_EPS);
    GAS unsigned long long* o8 = (GAS unsigned long long*)orow + lane;
#pragma unroll
    for (int j = 0; j < 8; ++j) { const f32x4 gg = gr[64 * j]; const float y0 = v[j].x * r * gg.x, y1 = v[j].y * r * gg.y, y2 = v[j].z * r * gg.z, y3 = v[j].w * r * gg.w;
        o8[64 * j] = (unsigned long long)pk2(y0, y1) | ((unsigned long long)pk2(y2, y3) << 32); ((GAS unsigned*)orow8)[64 * j + lane] = pk4f8(y0, y1, y2, y3); }
}
__device__ __forceinline__ void rms_row2_to_bf16(const float* xa, const float* xb_, const float* g, bf16* oa, bf16* ob, unsigned char* oa8, unsigned char* ob8, int lane) {
    const GAS f32x4* xra = (const GAS f32x4*)xa + lane; const GAS f32x4* xrb = (const GAS f32x4*)xb_ + lane; const GAS f32x4* gr = (const GAS f32x4*)g + lane;
    f32x4 va[8], vb[8]; float sa = 0.f, sb = 0.f;
#pragma unroll
    for (int j = 0; j < 8; ++j) { va[j] = xra[64 * j]; vb[j] = xrb[64 * j]; }
#pragma unroll
    for (int j = 0; j < 8; ++j) { sa += (va[j].x * va[j].x + va[j].y * va[j].y) + (va[j].z * va[j].z + va[j].w * va[j].w); sb += (vb[j].x * vb[j].x + vb[j].y * vb[j].y) + (vb[j].z * vb[j].z + vb[j].w * vb[j].w); }
    const float ra = 1.0f / sqrtf(wave_sum(sa) * (1.f / DM) + RMS_EPS), rb = 1.0f / sqrtf(wave_sum(sb) * (1.f / DM) + RMS_EPS);
    (void)oa; (void)ob;
#pragma unroll
    for (int j = 0; j < 8; ++j) { const f32x4 gg = gr[64 * j];
        { const float y0 = va[j].x * ra * gg.x, y1 = va[j].y * ra * gg.y, y2 = va[j].z * ra * gg.z, y3 = va[j].w * ra * gg.w;
          ((GAS unsigned*)oa8)[64 * j + lane] = pk4f8(y0, y1, y2, y3); }
        { const float y0 = vb[j].x * rb * gg.x, y1 = vb[j].y * rb * gg.y, y2 = vb[j].z * rb * gg.z, y3 = vb[j].w * rb * gg.w;
          ((GAS unsigned*)ob8)[64 * j + lane] = pk4f8(y0, y1, y2, y3); } }
}
__device__ __forceinline__ void rms_row_f32_inplace(float* xrow, const float* g, int lane) {
    GAS f32x4* xr = (GAS f32x4*)xrow + lane; const GAS f32x4* gr = (const GAS f32x4*)g + lane;
    f32x4 v[8]; float s = 0.f;
#pragma unroll
    for (int j = 0; j < 8; ++j) { v[j] = xr[64 * j]; s += (v[j].x * v[j].x + v[j].y * v[j].y) + (v[j].z * v[j].z + v[j].w * v[j].w); }
    const float r = 1.0f / sqrtf(wave_sum(s) * (1.f / DM) + RMS_EPS);
#pragma unroll
    for (int j = 0; j < 8; ++j) { const f32x4 gg = gr[64 * j]; xr[64 * j] = (f32x4){v[j].x * r * gg.x, v[j].y * r * gg.y, v[j].z * r * gg.z, v[j].w * r * gg.w}; }
}
__device__ __forceinline__ void fin_row(const bf16* xrow, float ssq, const float* g, float* orow, int lane) {
    const float r = 1.0f / sqrtf(ssq * (1.f / DM) + RMS_EPS);
    v4u b[4];
#pragma unroll
    for (int j = 0; j < 4; ++j) b[j] = *(const GAS v4u*)(xrow + 512 * j + 8 * lane);
#pragma unroll
    for (int j = 0; j < 4; ++j) { const GAS f32x4* gp = (const GAS f32x4*)(g + 512 * j + 8 * lane); const f32x4 g0 = gp[0], g1 = gp[1];
        const f32x4 y0 = {pg8::bf_lo(b[j][0]) * r * g0.x, pg8::bf_hi(b[j][0]) * r * g0.y, pg8::bf_lo(b[j][1]) * r * g0.z, pg8::bf_hi(b[j][1]) * r * g0.w};
        const f32x4 y1 = {pg8::bf_lo(b[j][2]) * r * g1.x, pg8::bf_hi(b[j][2]) * r * g1.y, pg8::bf_lo(b[j][3]) * r * g1.z, pg8::bf_hi(b[j][3]) * r * g1.w};
        GAS f32x4* op = (GAS f32x4*)(orow + 512 * j + 8 * lane); op[0] = y0; op[1] = y1; }
}
__device__ __forceinline__ void sincos_d(double a, double& s, double& c) {
    const double TWO_PI = 6.283185307179586476925286766559;
    const double k = rint(a / TWO_PI); const double x = a - k * TWO_PI, x2 = x * x;
    double ts = 1.0, tc = 1.0, ss = 1.0, cc = 1.0;
#pragma unroll 1
    for (int n = 1; n <= 16; ++n) { tc = -tc * x2 / (double)((2 * n - 1) * (2 * n)); ts = -ts * x2 / (double)((2 * n) * (2 * n + 1)); cc += tc; ss += ts; }
    s = ss * x; c = cc;
}

struct Args { const float* in[12]; float* out; unsigned char* ws; int ph_lo, ph_hi, li, pad; };

__global__ void __launch_bounds__(NWAVES * 64, 2) enc_fwd(Args args) {
    extern __shared__ __attribute__((aligned(16))) unsigned char lds[];
    LAS unsigned char* ldsl = (LAS unsigned char*)lds;
    volatile LAS unsigned* MISC = (volatile LAS unsigned*)(ldsl + MISC_OFF);
    const int tid = threadIdx.x;
    const int G = gridDim.x, bx = blockIdx.x;
    const int vcu = (G % 8 == 0) ? (bx % 8) * (G / 8) + bx / 8 : bx;
    unsigned char* ws = args.ws;
    gu32* ctl = (gu32*)(ws + WS_CTL);
    for (int u = tid; u < (LDS_BYTES - LDSCTL_OFF) / 4; u += NWAVES * 64) ((LAS unsigned*)(ldsl + LDSCTL_OFF))[u] = 0u;
    __syncthreads();
    XcdBarrier bar; bar.bar = (unsigned*)(ctl + CW_BAR); bar.x = 0; bar.st = nullptr;
    const int lo = args.ph_lo, hi = args.ph_hi;
    if (hi - lo > 1) bar = xcd_barrier_post((unsigned*)(ctl + CW_BAR) + args.li * XCD_BAR_WORDS, MISC + 8);
#define IN(k) (lo <= (k) && (k) < hi)
#define SEAM(k) do { if (IN((k) + 1)) xcd_barrier(bar); } while (0)

#define PH_ARGS() const __attribute__((address_space(4))) Args* A_ = (const __attribute__((address_space(4))) Args*)__builtin_amdgcn_kernarg_segment_ptr(); asm volatile("" : "+s"(A_)); unsigned char* const ws_ = A_->ws; (void)ws_
#define x_prompt (A_->in[0])
#define x_sample (A_->in[1])
#define g_mix (A_->in[2])
#define w_in (A_->in[3])
#define g_q (A_->in[4])
#define g_k (A_->in[5])
#define w_branch (A_->in[6])
#define w_out (A_->in[7])
#define g_mlp (A_->in[8])
#define w_ff1 (A_->in[9])
#define w_ff2 (A_->in[10])
#define g_final (A_->in[11])
#define Win_t ((bf16*)(ws_ + WS_WIN))
#define Wbr_t ((bf16*)(ws_ + WS_WBR))
#define Wout_t ((bf16*)(ws_ + WS_WOUT))
#define Wff1_t ((bf16*)(ws_ + WS_WFF1))
#define Wff2_t ((bf16*)(ws_ + WS_WFF2))
#define HB ((bf16*)(ws_ + WS_HB))
#define PROJ ((bf16*)(ws_ + WS_PROJ))
#define UB ((bf16*)(ws_ + WS_PROJ))
#define Q8 (ws_ + WS_Q8)
#define K8 (ws_ + WS_K8)
#define V8 (ws_ + WS_V8)
#define OG ((bf16*)(ws_ + WS_OG))
#define MG ((bf16*)(ws_ + WS_OG))
#define LSE ((float*)(ws_ + WS_LSE))
#define YB ((bf16*)(ws_ + WS_Y))
#define H2B ((bf16*)(ws_ + WS_Y))
#define ROPE ((float2*)(ws_ + WS_ROPE))
#define HB8 (ws_ + WS_HB8)
#define X2B ((bf16*)(ws_ + WS_HB))
#define Win8_t (ws_ + WS_WIN)
#define Wout8_t (ws_ + WS_WOUT8)
#define Wbr8_t (ws_ + WS_WBR8)
#define XS_ ((s == 0) ? x_prompt : x_sample + (size_t)(s - 1) * SEQ * DM)
#define OUTS_ (A_->out + (size_t)s * SEQ * DM)
    const int NGW = G * NWAVES, NGT = NGW * 64;
#define LANE_IDS() const int tid_ = pg8::otid(), lane = tid_ & 63, wave = __builtin_amdgcn_readfirstlane(tid_ >> 6), gw = vcu * NWAVES + wave, gt = gw * 64 + lane; (void)gt; (void)gw; (void)lane

    if (IN(0)) {
        PH_ARGS(); LANE_IDS();
        LAS float* scr = (LAS float*)(ldsl + RING_OFF + wave * 16384);
        constexpr int I_IN = (DM / 64) * (INW / 32), I_SQ = (DM / 64) * (DM / 32), I_F1 = (DM / 64) * (DFF / 32), I_F2 = (DFF / 64) * (DM / 32);
        constexpr int NITEMS = I_IN + 2 * I_SQ + I_F1 + I_F2;
        for (int it = gw; it < NITEMS; it += NGW) {
            int r = it;
            if (r < I_IN) { if ((r % (INW / 32)) * 32 < N_IN_BF16) p0_transpose_item<false>(w_in, DM, INW, Win_t, nullptr, scr, r, lane);
                            else p0_transpose_item_fp8(w_in, DM, INW, Win8_t, N_IN_BF16, 64.0f, scr, r, lane, C_GA); continue; } r -= I_IN;
            if (r < I_SQ) { p0_transpose_item_fp8(w_branch, DM, DM, Wbr8_t, 0, 32.0f, scr, r, lane); continue; } r -= I_SQ;
            if (r < I_SQ) { p0_transpose_item_fp8(w_out, DM, DM, Wout8_t, 0, 64.0f, scr, r, lane); continue; } r -= I_SQ;
            if (r < I_F1) { p0_transpose_item<true>(w_ff1, DM, DFF, Wff1_t, g_mlp, scr, r, lane); continue; } r -= I_F1;
            p0_transpose_item<false>(w_ff2, DFF, DM, Wff2_t, nullptr, scr, r, lane);
        }
        for (int i = gt; i < 256 * 32; i += NGT) {
            const int pos = i >> 5, f = i & 31;
            double iv = 1.0; for (int q = 0; q < f; ++q) iv *= 0.7498942093324559;
            const float invf = (float)iv;
            const float ang = (float)pos * invf; double s, c; sincos_d((double)ang, s, c);
            ROPE[i] = make_float2((float)c, (float)s);
        }
        for (int m = gw; m < SEQ; m += 2 * NGW) { const int m2 = m + NGW; rms_row2_to_bf16(x_prompt + (size_t)m * DM, x_prompt + (size_t)m2 * DM, g_mix, HB + (size_t)m * DM, HB + (size_t)m2 * DM, HB8 + (size_t)m * DM, HB8 + (size_t)m2 * DM, lane); }
        SEAM(0);
    }

    for (int s = 0; s < NSEQ; ++s) {
        const int pb = 1 + 7 * s;

        if (IN(pb + 0)) {
            PH_ARGS();
            if (s > 0) { LANE_IDS(); const float* ss2 = (const float*)(ws_ + WS_SS2) + (size_t)(s - 1) * SEQ; float* op = A_->out + (size_t)(s - 1) * SEQ * DM;
                for (int m = gw; m < SEQ; m += NGW) fin_row(X2B + (size_t)m * DM, ss2[m], g_final, op + (size_t)m * DM, lane);
                __syncthreads(); }
            { pg8::Gemm g{HB, Win_t, SEQ, N_IN_BF16, DM}; pg8::StaticOrder S; S.init(SEQ, N_IN_BF16, G, bx);
              pg8::EpiBf16<0> E{PROJ, INW, 1.0f, nullptr};
              pg8::gemm_phase<pg8::EpiBf16<0>, pg8::StaticOrder, true, true>(ldsl + RING_OFF, g, S, E); }
            __syncthreads();
            { pg8::Gemm g{(const bf16*)HB8, (const bf16*)Win8_t, SEQ, INW - N_IN_BF16, DM / 2}; pg8::StaticOrder S; S.init(SEQ, INW - N_IN_BF16, G, bx, WGM_B);
              pg8::EpiBf16<0, false, (C_GA - N_IN_BF16) / 256> E{PROJ + N_IN_BF16, INW, 1.0f / 64.0f, nullptr};
              pg8::gemm_phase<pg8::EpiBf16<0, false, (C_GA - N_IN_BF16) / 256>, pg8::StaticOrder, true, true, true>(ldsl + RING_OFF, g, S, E); }
            SEAM(pb + 0);
        }
        if (IN(pb + 1)) {
            PH_ARGS();
            {   LANE_IDS();
                const int j = gt & 7, a = j >> 2, jj = j & 3;
#pragma unroll 2
                for (int item = gt >> 3; item < SEQ * 16; item += NGT >> 3) {
                    const int t = item >> 4, hh = item & 15;
                    const bf16* src; unsigned char* dst1; unsigned char* dst2; const float* gg; float osc;
                    const int o1 = 64 * a + 8 * jj, o2 = o1 + 32;
                    if (hh < 12) { src = PROJ + (size_t)t * INW + C_BQ + hh * 128; dst1 = Q8 + (size_t)t * 1536 + hh * 128 + o1; dst2 = dst1 + 32; gg = g_q; osc = att::SCALE * LOG2E * 8.0f; }
                    else { src = PROJ + (size_t)t * INW + C_BK + (hh - 12) * 128; gg = g_k; osc = 0.125f;
                        const int ki = t & 63, sw = (ki >> 1) & 7; unsigned char* tb = K8 + ((size_t)(hh - 12) * 256 + (t >> 6)) * 8192 + ki * 128;
                        dst1 = tb + ((((o1 >> 4) ^ sw)) << 4) + (o1 & 15); dst2 = tb + ((((o2 >> 4) ^ sw)) << 4) + (o2 & 15); }
                    const v4u w1 = *(const GAS v4u*)(src + o1), w2 = *(const GAS v4u*)(src + o2);
                    float x1[8], x2[8]; float ss = 0.f;
#pragma unroll
                    for (int e = 0; e < 4; ++e) { x1[2 * e] = pg8::bf_lo(w1[e]); x1[2 * e + 1] = pg8::bf_hi(w1[e]); x2[2 * e] = pg8::bf_lo(w2[e]); x2[2 * e + 1] = pg8::bf_hi(w2[e]); }
#pragma unroll
                    for (int e = 0; e < 8; ++e) ss += x1[e] * x1[e] + x2[e] * x2[e];
                    ss += __shfl_xor(ss, 1); ss += __shfl_xor(ss, 2); ss += __shfl_xor(ss, 4);
                    const float rinv = osc / sqrtf(ss * (1.f / 128.f) + RMS_EPS);
                    const int pos = (a == 0) ? (t >> 6) : (t & 63);
                    const float2* rt_ = ROPE + pos * 32 + 8 * jj;
                    float y1[8], y2[8];
#pragma unroll
                    for (int e = 0; e < 8; ++e) { const float2 cs = rt_[e]; const float u1 = x1[e] * rinv * gg[o1 + e], u2 = x2[e] * rinv * gg[o2 + e];
                        y1[e] = u1 * cs.x - u2 * cs.y; y2[e] = u2 * cs.x + u1 * cs.y; }
                    int q1a = 0, q1b = 0, q2a = 0, q2b = 0;
                    q1a = __builtin_amdgcn_cvt_pk_fp8_f32(y1[0], y1[1], q1a, false); q1a = __builtin_amdgcn_cvt_pk_fp8_f32(y1[2], y1[3], q1a, true);
                    q1b = __builtin_amdgcn_cvt_pk_fp8_f32(y1[4], y1[5], q1b, false); q1b = __builtin_amdgcn_cvt_pk_fp8_f32(y1[6], y1[7], q1b, true);
                    q2a = __builtin_amdgcn_cvt_pk_fp8_f32(y2[0], y2[1], q2a, false); q2a = __builtin_amdgcn_cvt_pk_fp8_f32(y2[2], y2[3], q2a, true);
                    q2b = __builtin_amdgcn_cvt_pk_fp8_f32(y2[4], y2[5], q2b, false); q2b = __builtin_amdgcn_cvt_pk_fp8_f32(y2[6], y2[7], q2b, true);
                    *(GAS unsigned long long*)dst1 = (unsigned long long)(unsigned)q1a | ((unsigned long long)(unsigned)q1b << 32);
                    *(GAS unsigned long long*)dst2 = (unsigned long long)(unsigned)q2a | ((unsigned long long)(unsigned)q2b << 32);
                }
                for (int item = gt; item < 256 * 4 * 4 * 128; item += NGT) {
                    const int d = item & 127, q = (item >> 7) & 3, kvh = (item >> 9) & 3, tile = item >> 11, h = q >> 1, half = q & 1;
                    const bf16* vp = PROJ + (size_t)(tile * 64 + 32 * half + 4 * h) * INW + C_BV + kvh * 128 + d;
                    float f[16];
#pragma unroll
                    for (int pp = 0; pp < 16; ++pp) f[pp] = __uint_as_float((unsigned)vp[(size_t)((pp & 3) + 8 * (pp >> 2)) * INW] << 16);
                    v4u w;
#pragma unroll
                    for (int e = 0; e < 4; ++e) { int x = 0; x = __builtin_amdgcn_cvt_pk_fp8_f32(f[4 * e], f[4 * e + 1], x, false); x = __builtin_amdgcn_cvt_pk_fp8_f32(f[4 * e + 2], f[4 * e + 3], x, true); w[e] = (unsigned)x; }
                    *(GAS v4u*)(V8 + ((size_t)kvh * 256 + tile) * 8192 + d * 64 + ((q ^ ((d >> 2) & 3)) << 4)) = w;
                }
            }
            if (s + 1 < NSEQ) { LANE_IDS(); const float* xn = x_sample + (size_t)s * SEQ * DM;
                for (int m = gw; m < SEQ; m += 2 * NGW) { const int m2 = m + NGW; rms_row2_to_bf16(xn + (size_t)m * DM, xn + (size_t)m2 * DM, g_mix, HB + (size_t)m * DM, HB + (size_t)m2 * DM, HB8 + (size_t)m * DM, HB8 + (size_t)m2 * DM, lane); } }
            __syncthreads();
            for (int u = vcu; u < 768; u += G) {
                const int g = u >> 8, h = (u >> 6) & 3, rb = u & 63;
                const int d = (g == 0) ? 1 : (g == 1 ? 4 : 16), nblk = (SEQ / d) / 256;
                const int res = rb / nblk, blk = rb % nblk;
                att::dil_unit((const att::bf16*)PROJ, OG, LSE, g, h, res, blk * 256, (char*)lds + RING_OFF);
            }
            SEAM(pb + 1);
        }
        if (IN(pb + 2)) {
            PH_ARGS();
            { LANE_IDS();
            for (int item = gt; item < SEQ * 64; item += NGT) {
                const int t = item >> 6, h = (item >> 4) & 3, c = item & 15;
                const float l0 = LSE[(size_t)t * 12 + h], l1 = LSE[(size_t)t * 12 + 4 + h], l2 = LSE[(size_t)t * 12 + 8 + h];
                const float mx = fmaxf(l0, fmaxf(l1, l2)); float e0 = __expf(l0 - mx), e1 = __expf(l1 - mx), e2 = __expf(l2 - mx);
                const float rs = 1.0f / (e0 + e1 + e2); e0 *= rs; e1 *= rs; e2 *= rs;
                const bf16* o0 = OG + (size_t)t * 1536 + h * 128 + 8 * c;
                const v4u ua = *(const GAS v4u*)(o0), ub = *(const GAS v4u*)(o0 + 512), uc = *(const GAS v4u*)(o0 + 1024);
                const f32x4 a0 = {pg8::bf_lo(ua[0]), pg8::bf_hi(ua[0]), pg8::bf_lo(ua[1]), pg8::bf_hi(ua[1])}, a1 = {pg8::bf_lo(ua[2]), pg8::bf_hi(ua[2]), pg8::bf_lo(ua[3]), pg8::bf_hi(ua[3])};
                const f32x4 b0 = {pg8::bf_lo(ub[0]), pg8::bf_hi(ub[0]), pg8::bf_lo(ub[1]), pg8::bf_hi(ub[1])}, b1 = {pg8::bf_lo(ub[2]), pg8::bf_hi(ub[2]), pg8::bf_lo(ub[3]), pg8::bf_hi(ub[3])};
                const f32x4 c0 = {pg8::bf_lo(uc[0]), pg8::bf_hi(uc[0]), pg8::bf_lo(uc[1]), pg8::bf_hi(uc[1])}, c1 = {pg8::bf_lo(uc[2]), pg8::bf_hi(uc[2]), pg8::bf_lo(uc[3]), pg8::bf_hi(uc[3])};
                const f32x4 r0 = a0 * e0 + b0 * e1 + c0 * e2, r1 = a1 * e0 + b1 * e1 + c1 * e2;
                const unsigned w0 = pk4f8(r0.x * 4.f, r0.y * 4.f, r0.z * 4.f, r0.w * 4.f), w1 = pk4f8(r1.x * 4.f, r1.y * 4.f, r1.z * 4.f, r1.w * 4.f);
                *(GAS unsigned long long*)((unsigned char*)YB + (size_t)t * DM + h * 128 + 8 * c) = (unsigned long long)w0 | ((unsigned long long)w1 << 32);
            } }
            for (int u = vcu; u < 768; u += G) {
                const int hq = u >> 6, qb = u & 63, kvh = hq / 3;
                __syncthreads();
                att8::attn8_body<1536, DM>(Q8 + (size_t)qb * 256 * 1536 + hq * 128, K8 + (size_t)kvh * 256 * 8192, V8 + (size_t)kvh * 256 * 8192,
                                           (unsigned char*)YB + (size_t)qb * 256 * DM + 512 + hq * 128, SEQ / 64, ldsl + RING_OFF);
            }
            SEAM(pb + 2);
        }
        if (IN(pb + 3)) {
            PH_ARGS();
            __syncthreads();
            pg8::Gemm g{YB, (const bf16*)Wbr8_t, SEQ, DM, DM / 2}; pg8::StaticOrder S; S.init(SEQ, DM, G, bx, WGM_E);
            pg8::EpiGate E{MG, DM, PROJ, INW, C_GA, (unsigned)((size_t)SEQ * INW * 2)};
            pg8::gemm_phase<pg8::EpiGate, pg8::StaticOrder, true, true, true>(ldsl + RING_OFF, g, S, E);
            SEAM(pb + 3);
        }
        if (IN(pb + 4)) {
            PH_ARGS();
            pg8::Gemm g{MG, (const bf16*)Wout8_t, SEQ, DM, DM / 2}; pg8::StaticOrder S; S.init(SEQ, DM, G, bx, WGM_F);
            pg8::EpiResBf16Stats E{XS_, H2B, DM, (float*)(ws_ + WS_SS) + (size_t)s * SEQ, 1.0f / 512.0f};
            pg8::gemm_phase<pg8::EpiResBf16Stats, pg8::StaticOrder, true, true, true>(ldsl + RING_OFF, g, S, E);
            SEAM(pb + 4);
        }
        if (IN(pb + 5)) {
            PH_ARGS();
            pg8::Gemm g{H2B, Wff1_t, SEQ, DFF, DM}; pg8::StaticOrder S; S.init(SEQ, DFF, G, bx, WGM_H);
            pg8::EpiBf16<2, true> E{UB, DFF, 1.0f, (const float*)(ws_ + WS_SS) + (size_t)s * SEQ};
            pg8::gemm_phase<pg8::EpiBf16<2, true>, pg8::StaticOrder, true, true>(ldsl + RING_OFF, g, S, E);
            SEAM(pb + 5);
        }
        if (IN(pb + 6)) {
            PH_ARGS();
            pg8::Gemm g{UB, Wff2_t, SEQ, DM, DFF}; pg8::StaticOrder S; S.init(SEQ, DM, G, bx, WGM_I);
            pg8::EpiResBf16FromBf16Stats E{H2B, X2B, DM, (float*)(ws_ + WS_SS2) + (size_t)s * SEQ};
            pg8::gemm_phase<pg8::EpiResBf16FromBf16Stats, pg8::StaticOrder, true, true>(ldsl + RING_OFF, g, S, E);
            SEAM(pb + 6);
        }
    }
    if (IN(22)) {
        PH_ARGS(); LANE_IDS();
        { const float* ss2 = (const float*)(ws_ + WS_SS2) + (size_t)(NSEQ - 1) * SEQ; float* op = A_->out + (size_t)(NSEQ - 1) * SEQ * DM;
          for (int m = gw; m < SEQ; m += NGW) fin_row(X2B + (size_t)m * DM, ss2[m], g_final, op + (size_t)m * DM, lane); }
    }
#undef IN
#undef SEAM
}

extern "C" void kernel_launch(void* const* d_in, const int* in_sizes, int n_in, void* d_out, int out_size, void* d_ws, size_t ws_size, hipStream_t stream) {
    static int grid = 0;
    if (grid == 0) {
        if (n_in != 12 || ws_size < WS_END) { fprintf(stderr, "kernel_launch: expected 12 inputs and >= %zu bytes of workspace; got n_in %d ws %zu\n", (size_t)WS_END, n_in, ws_size); grid = -1; return; }
        int dev = 0, cus = 0, per_cu = 0;
        if (hipGetDevice(&dev) != hipSuccess || hipDeviceGetAttribute(&cus, hipDeviceAttributeMultiprocessorCount, dev) != hipSuccess) { grid = -1; return; }
        if (hipFuncSetAttribute((const void*)enc_fwd, hipFuncAttributeMaxDynamicSharedMemorySize, LDS_BYTES) != hipSuccess) { fprintf(stderr, "kernel_launch: hipFuncSetAttribute failed\n"); grid = -1; return; }
        if (hipOccupancyMaxActiveBlocksPerMultiprocessor(&per_cu, (const void*)enc_fwd, NWAVES * 64, LDS_BYTES) != hipSuccess || per_cu < 1)
            fprintf(stderr, "kernel_launch: occupancy query reports %d workgroups per CU\n", per_cu);
        (void)hipGetLastError();
        grid = cus;
    }
    if (grid < 0) return;
    if (hipMemsetAsync((char*)d_ws + WS_CTL, 0, CTL_ZERO_BYTES, stream) != hipSuccess) return;
    Args a{};
    for (int i = 0; i < 12; ++i) a.in[i] = (const float*)d_in[i];
    a.out = (float*)d_out; a.ws = (unsigned char*)d_ws;
#if MK_N_LAUNCHES == 1
    a.ph_lo = 0; a.ph_hi = N_PHASES; a.li = 0;
    hipLaunchKernelGGL(enc_fwd, dim3(grid), dim3(NWAVES * 64), LDS_BYTES, stream, a);
#else
    for (int p = 0; p < N_PHASES; ++p) { a.ph_lo = p; a.ph_hi = p + 1; a.li = 0;
        hipLaunchKernelGGL(enc_fwd, dim3(grid), dim3(NWAVES * 64), LDS_BYTES, stream, a); }
#endif
    const hipError_t le = hipPeekAtLastError();
    if (le != hipSuccess) fprintf(stderr, "kernel_launch: launch failed: %s\n", hipGetErrorName(le));
}
```

```cpp
#include <hip/hip_runtime.h>
#include <cstdio>
#include <cstdint>

#ifndef MK_N_LAUNCHES
#define MK_N_LAUNCHES 1
#endif

namespace pg8 {
#define PG8_LAS __attribute__((address_space(3)))
typedef unsigned short bf16_t;
typedef short bf16x8 __attribute__((ext_vector_type(8)));
typedef float f32x4 __attribute__((ext_vector_type(4)));
typedef unsigned u32x4 __attribute__((ext_vector_type(4)));
typedef int v8i_t __attribute__((ext_vector_type(8)));
typedef int v4i_t __attribute__((ext_vector_type(4)));
constexpr int BM = 256, BK = 64, HALF = 128, HTB = HALF * BK * 2  , STAGE_BYTES = 8 * HTB, NXCD = 8;

__host__ __device__ __forceinline__ int lds_byte(int r, int c) { const int st = (r >> 4) * 2 + (c >> 5), rr = r & 15, cc = c & 31, ob = rr * 64 + cc * 2; return st * 1024 + (ob ^ (((ob >> 9) & 1) << 5)); }
__host__ __device__ __forceinline__ void stage_rc(int b, int& R, int& C) { const int st = b / 1024, sb = b % 1024, swz = sb ^ (((sb >> 9) & 1) << 5); R = (st >> 1) * 16 + swz / 64; C = (st & 1) * 32 + (swz % 64) / 2; }
__host__ __device__ __forceinline__ int perm32(int rho) { const int n = rho >> 4, i = rho & 15; return 8 * (i >> 2) + 4 * n + (i & 3); }

struct Unit { int pm, pn; };
struct Gemm { const bf16_t* A; const bf16_t* Bt; int M, N, K; };

struct StaticOrder {
    int nM, nN, nwg, G, c, WGM;
    __host__ __device__ void init(int M, int N, int G_, int c_, int wgm = 4) { nM = M / BM; nN = N / BM; nwg = nM * nN; G = G_; c = c_; WGM = wgm; }
    __host__ __device__ bool next(int i, Unit& u) const {
        const long L = (long)i * G + c; if (L >= nwg) return false;
        int wgid = (int)L; { const int q = nwg / NXCD, r = nwg % NXCD, xcd = wgid % NXCD, off = wgid / NXCD; wgid = (xcd < r ? xcd * (q + 1) : r * (q + 1) + (xcd - r) * q) + off; }
        const int nig = WGM * nN, gid = wgid / nig, fm = gid * WGM, gsz = (nM - fm) < WGM ? (nM - fm) : WGM;
        u.pm = fm + ((wgid % nig) % gsz); u.pn = (wgid % nig) / gsz; return true;
    }
    __device__ __forceinline__ void a_ready(const Unit&) const {}
    __device__ __forceinline__ void done(const Unit&) const {}
};


__device__ __forceinline__ int otid() { int t = threadIdx.x; asm volatile("" : "+v"(t)); return t; }
__device__ __forceinline__ unsigned cvt_pk_bf16(float lo, float hi) { unsigned r; asm volatile("v_cvt_pk_bf16_f32 %0, %1, %2" : "=v"(r) : "v"(lo), "v"(hi)); return r; }
__device__ __forceinline__ float bf_lo(unsigned w) { return __uint_as_float(w << 16); }
__device__ __forceinline__ float bf_hi(unsigned w) { return __uint_as_float(w & 0xffff0000u); }

template <int ACT, bool ROWSS = false, int GATE_PN = (1 << 30)> struct EpiBf16 {
    static constexpr bool PERM = true, AFTER_DRAIN = false, HAS_MID = false; static constexpr int MID_T = -1;
    bf16_t* O; int ldc; float osc; const float* rowss;
    __device__ __forceinline__ void mid(f32x4 (&)[2][2][4][2], const Unit&, int, int, int, int) const {}
    __device__ __forceinline__ void operator()(const f32x4 (&acc)[2][2][4][2], const Unit& u, int wr, int wc, int fr, int fq) const {
        const int row0 = u.pm * BM + wr * 64 + fr; const int col0 = u.pn * BM + wc * 32 + 8 * fq;
        float rs[2][4];
#pragma unroll
        for (int ai = 0; ai < 2; ++ai)
#pragma unroll
            for (int m = 0; m < 4; ++m) rs[ai][m] = ROWSS ? rowss[row0 + ai * HALF + m * 16] : osc;
        __builtin_amdgcn_sched_barrier(0);
        if constexpr (ROWSS) {
#pragma unroll
            for (int ai = 0; ai < 2; ++ai)
#pragma unroll
                for (int m = 0; m < 4; ++m) rs[ai][m] = osc * __builtin_amdgcn_rsqf(rs[ai][m] * (1.0f / 2048.0f) + 1e-6f); }
        if (GATE_PN < (1 << 30) && u.pn >= GATE_PN) {
#pragma unroll
            for (int ai = 0; ai < 2; ++ai)
#pragma unroll
                for (int m = 0; m < 4; ++m) { bf16_t* rowp = O + (size_t)(row0 + ai * HALF + m * 16) * ldc + col0; f32x4 r_[2], s_[2];
#pragma unroll
                    for (int n = 0; n < 2; ++n)
#pragma unroll
                        for (int e = 0; e < 4; ++e) { const float ea = __expf(-acc[ai][0][m][n][e] * osc), eb = __expf(-acc[ai][1][m][n][e] * osc);
                            r_[n][e] = 16.f * (1.f + eb) * __builtin_amdgcn_rcpf(1.f + ea); s_[n][e] = __builtin_amdgcn_rcpf(1.f + eb); }
                    u32x4 w; w.x = cvt_pk_bf16(r_[0][0], r_[0][1]); w.y = cvt_pk_bf16(r_[0][2], r_[0][3]); w.z = cvt_pk_bf16(r_[1][0], r_[1][1]); w.w = cvt_pk_bf16(r_[1][2], r_[1][3]);
                    *(u32x4*)(rowp) = w;
                    w.x = cvt_pk_bf16(s_[0][0], s_[0][1]); w.y = cvt_pk_bf16(s_[0][2], s_[0][3]); w.z = cvt_pk_bf16(s_[1][0], s_[1][1]); w.w = cvt_pk_bf16(s_[1][2], s_[1][3]);
                    *(u32x4*)(rowp + HALF) = w; }
            return; }
#pragma unroll
        for (int ai = 0; ai < 2; ++ai)
#pragma unroll
            for (int m = 0; m < 4; ++m) { bf16_t* rowp = O + (size_t)(row0 + ai * HALF + m * 16) * ldc + col0;
#pragma unroll
                for (int bj = 0; bj < 2; ++bj) { f32x4 v0 = acc[ai][bj][m][0] * rs[ai][m], v1 = acc[ai][bj][m][1] * rs[ai][m];
                    if (ACT == 2) {
#pragma unroll
                        for (int e = 0; e < 4; ++e) { float a = fmaxf(v0[e], 0.f), b = fmaxf(v1[e], 0.f); v0[e] = a * a; v1[e] = b * b; } }
                    u32x4 w; w.x = cvt_pk_bf16(v0[0], v0[1]); w.y = cvt_pk_bf16(v0[2], v0[3]); w.z = cvt_pk_bf16(v1[0], v1[1]); w.w = cvt_pk_bf16(v1[2], v1[3]);
                    *(u32x4*)(rowp + bj * HALF) = w; } }
    }
};
struct EpiGate {
    static constexpr bool PERM = true, AFTER_DRAIN = false, HAS_MID = true; static constexpr int MID_T = 4;
    bf16_t* O; int ldc; const bf16_t* G; int ldg, ga0; unsigned gbytes;
    __device__ __forceinline__ void mid(f32x4 (&acc)[2][2][4][2], const Unit& u, int wr, int wc, int fr, int fq) const {
        const __amdgpu_buffer_rsrc_t rs = __builtin_amdgcn_make_buffer_rsrc((void*)G, 0, gbytes, 0x00020000);
        const int voff = ((wr * 64 + fr) * ldg + wc * 32 + 8 * fq) * 2;
        const int sb = (u.pm * BM * ldg + ga0 + u.pn * 2 * BM) * 2;
        u32x4 gr[2][4][2];
#pragma unroll
        for (int ai = 0; ai < 2; ++ai)
#pragma unroll
            for (int m = 0; m < 4; ++m) { const int so = sb + (ai * HALF + m * 16) * ldg * 2;
#pragma unroll
                for (int bj = 0; bj < 2; ++bj) gr[ai][m][bj] = __builtin_amdgcn_raw_buffer_load_b128(rs, voff, so + bj * BM * 2, 0); }
        __builtin_amdgcn_sched_barrier(0);
#pragma unroll
        for (int ai = 0; ai < 2; ++ai)
#pragma unroll
            for (int m = 0; m < 4; ++m)
#pragma unroll
                for (int bj = 0; bj < 2; ++bj) { const u32x4 a = gr[ai][m][bj];
#pragma unroll
                    for (int e = 0; e < 4; ++e) { acc[ai][bj][m][e >> 1][(e & 1) * 2 + 0] *= bf_lo(a[e]); acc[ai][bj][m][e >> 1][(e & 1) * 2 + 1] *= bf_hi(a[e]); } }
        __builtin_amdgcn_sched_barrier(0);
    }
    __device__ __forceinline__ void operator()(const f32x4 (&acc)[2][2][4][2], const Unit& u, int wr, int wc, int fr, int fq) const {
        const __amdgpu_buffer_rsrc_t rs = __builtin_amdgcn_make_buffer_rsrc((void*)G, 0, gbytes, 0x00020000);
        const int voff = ((wr * 64 + fr) * ldg + wc * 32 + 8 * fq) * 2;
        const int sb = (u.pm * BM * ldg + ga0 + u.pn * 2 * BM + HALF) * 2;
        const int row0 = u.pm * BM + wr * 64 + fr; const int col0 = u.pn * BM + wc * 32 + 8 * fq;
        u32x4 gb[2][4][2];
#pragma unroll
        for (int ai = 0; ai < 2; ++ai)
#pragma unroll
            for (int m = 0; m < 4; ++m) { const int so = sb + (ai * HALF + m * 16) * ldg * 2;
#pragma unroll
                for (int bj = 0; bj < 2; ++bj) gb[ai][m][bj] = __builtin_amdgcn_raw_buffer_load_b128(rs, voff, so + bj * BM * 2, 0); }
        __builtin_amdgcn_sched_barrier(0);
#pragma unroll
        for (int ai = 0; ai < 2; ++ai)
#pragma unroll
            for (int m = 0; m < 4; ++m) { const size_t r = (size_t)(row0 + ai * HALF + m * 16);
#pragma unroll
                for (int bj = 0; bj < 2; ++bj) { const u32x4 b = gb[ai][m][bj]; float v[8];
#pragma unroll
                    for (int e = 0; e < 4; ++e) { v[2 * e] = acc[ai][bj][m][e >> 1][(e & 1) * 2 + 0] * bf_lo(b[e]); v[2 * e + 1] = acc[ai][bj][m][e >> 1][(e & 1) * 2 + 1] * bf_hi(b[e]); }
                    int w0 = 0, w1 = 0;
                    constexpr float F_ = 8.f / 2048.f;
                    w0 = __builtin_amdgcn_cvt_pk_fp8_f32(v[0] * F_, v[1] * F_, w0, false); w0 = __builtin_amdgcn_cvt_pk_fp8_f32(v[2] * F_, v[3] * F_, w0, true);
                    w1 = __builtin_amdgcn_cvt_pk_fp8_f32(v[4] * F_, v[5] * F_, w1, false); w1 = __builtin_amdgcn_cvt_pk_fp8_f32(v[6] * F_, v[7] * F_, w1, true);
                    *(unsigned long long*)((unsigned char*)O + r * ldc + col0 + bj * HALF) = (unsigned long long)(unsigned)w0 | ((unsigned long long)(unsigned)w1 << 32); } }
    }
};
struct EpiResF32 {
    static constexpr bool PERM = false, AFTER_DRAIN = false, HAS_MID = false; static constexpr int MID_T = -1;
    const float* base; float* out; int ldc;
    __device__ __forceinline__ void mid(f32x4 (&)[2][2][4][2], const Unit&, int, int, int, int) const {}
    __device__ __forceinline__ void operator()(const f32x4 (&acc)[2][2][4][2], const Unit& u, int wr, int wc, int fr, int fq) const {
        const int row0 = u.pm * BM + wr * 64 + fr; const int col0 = u.pn * BM + wc * 32 + 4 * fq;
#pragma unroll
        for (int ai = 0; ai < 2; ++ai)
#pragma unroll
            for (int m = 0; m < 4; ++m) { const size_t off = (size_t)(row0 + ai * HALF + m * 16) * ldc + col0;
#pragma unroll
                for (int bj = 0; bj < 2; ++bj)
#pragma unroll
                    for (int n = 0; n < 2; ++n) { const f32x4 bs = *(const f32x4*)(base + off + bj * HALF + n * 16); *(f32x4*)(out + off + bj * HALF + n * 16) = bs + acc[ai][bj][m][n]; }
                if (m == 3) asm volatile("" ::: "memory"); }
    }
};

struct EpiResBf16Stats {
    static constexpr bool PERM = true, AFTER_DRAIN = false, HAS_MID = false; static constexpr int MID_T = -1;
    const float* base; bf16_t* xb; int ldc; float* ss; float osc;
    __device__ __forceinline__ void mid(f32x4 (&)[2][2][4][2], const Unit&, int, int, int, int) const {}
    __device__ __forceinline__ void operator()(const f32x4 (&acc)[2][2][4][2], const Unit& u, int wr, int wc, int fr, int fq) const {
        const int row0 = u.pm * BM + wr * 64 + fr; const int col0 = u.pn * BM + wc * 32 + 8 * fq;
#pragma unroll
        for (int ai = 0; ai < 2; ++ai) {
            f32x4 xr[4][2][2];
#pragma unroll
            for (int m = 0; m < 4; ++m) { const size_t off = (size_t)(row0 + ai * HALF + m * 16) * ldc + col0;
#pragma unroll
                for (int bj = 0; bj < 2; ++bj) { xr[m][bj][0] = *(const f32x4*)(base + off + bj * HALF); xr[m][bj][1] = *(const f32x4*)(base + off + bj * HALF + 4); } }
            __builtin_amdgcn_sched_barrier(0);
            float sq[4];
#pragma unroll
            for (int m = 0; m < 4; ++m) { const size_t off = (size_t)(row0 + ai * HALF + m * 16) * ldc + col0; float q = 0.f;
#pragma unroll
                for (int bj = 0; bj < 2; ++bj) { const f32x4 v0 = xr[m][bj][0] + acc[ai][bj][m][0] * osc, v1 = xr[m][bj][1] + acc[ai][bj][m][1] * osc;
                    q += (v0[0] * v0[0] + v0[1] * v0[1]) + (v0[2] * v0[2] + v0[3] * v0[3]) + (v1[0] * v1[0] + v1[1] * v1[1]) + (v1[2] * v1[2] + v1[3] * v1[3]);
                    u32x4 w; w.x = cvt_pk_bf16(v0[0], v0[1]); w.y = cvt_pk_bf16(v0[2], v0[3]); w.z = cvt_pk_bf16(v1[0], v1[1]); w.w = cvt_pk_bf16(v1[2], v1[3]);
                    *(u32x4*)(xb + off + bj * HALF) = w; }
                q += __shfl_xor(q, 16); q += __shfl_xor(q, 32); sq[m] = q; }
            if (fq == 0) {
#pragma unroll
                for (int m = 0; m < 4; ++m) unsafeAtomicAdd(ss + row0 + ai * HALF + m * 16, sq[m]); }
            __builtin_amdgcn_sched_barrier(0); }
    }
};
struct EpiResFromBf16 {
    static constexpr bool PERM = true, AFTER_DRAIN = false, HAS_MID = false; static constexpr int MID_T = -1;
    const bf16_t* xb; float* out; int ldc;
    __device__ __forceinline__ void mid(f32x4 (&)[2][2][4][2], const Unit&, int, int, int, int) const {}
    __device__ __forceinline__ void operator()(const f32x4 (&acc)[2][2][4][2], const Unit& u, int wr, int wc, int fr, int fq) const {
        const int row0 = u.pm * BM + wr * 64 + fr; const int col0 = u.pn * BM + wc * 32 + 8 * fq;
        u32x4 xr[2][4][2];
#pragma unroll
        for (int ai = 0; ai < 2; ++ai)
#pragma unroll
            for (int m = 0; m < 4; ++m) { const size_t off = (size_t)(row0 + ai * HALF + m * 16) * ldc + col0;
#pragma unroll
                for (int bj = 0; bj < 2; ++bj) xr[ai][m][bj] = *(const u32x4*)(xb + off + bj * HALF); }
        __builtin_amdgcn_sched_barrier(0);
#pragma unroll
        for (int ai = 0; ai < 2; ++ai)
#pragma unroll
            for (int m = 0; m < 4; ++m) { const size_t off = (size_t)(row0 + ai * HALF + m * 16) * ldc + col0;
#pragma unroll
                for (int bj = 0; bj < 2; ++bj) { const u32x4 b = xr[ai][m][bj];
                    const f32x4 x0 = {bf_lo(b[0]), bf_hi(b[0]), bf_lo(b[1]), bf_hi(b[1])}, x1 = {bf_lo(b[2]), bf_hi(b[2]), bf_lo(b[3]), bf_hi(b[3])};
                    *(f32x4*)(out + off + bj * HALF) = x0 + acc[ai][bj][m][0]; *(f32x4*)(out + off + bj * HALF + 4) = x1 + acc[ai][bj][m][1]; } }
    }
};
struct EpiResBf16FromBf16Stats {
    static constexpr bool PERM = true, AFTER_DRAIN = false, HAS_MID = false; static constexpr int MID_T = -1;
    const bf16_t* xb; bf16_t* ob; int ldc; float* ss;
    __device__ __forceinline__ void mid(f32x4 (&)[2][2][4][2], const Unit&, int, int, int, int) const {}
    __device__ __forceinline__ void operator()(const f32x4 (&acc)[2][2][4][2], const Unit& u, int wr, int wc, int fr, int fq) const {
        const int row0 = u.pm * BM + wr * 64 + fr; const int col0 = u.pn * BM + wc * 32 + 8 * fq;
        u32x4 xr[2][4][2];
#pragma unroll
        for (int ai = 0; ai < 2; ++ai)
#pragma unroll
            for (int m = 0; m < 4; ++m) { const size_t off = (size_t)(row0 + ai * HALF + m * 16) * ldc + col0;
#pragma unroll
                for (int bj = 0; bj < 2; ++bj) xr[ai][m][bj] = *(const u32x4*)(xb + off + bj * HALF); }
        __builtin_amdgcn_sched_barrier(0);
#pragma unroll
        for (int ai = 0; ai < 2; ++ai) { float sq[4];
#pragma unroll
            for (int m = 0; m < 4; ++m) { const size_t off = (size_t)(row0 + ai * HALF + m * 16) * ldc + col0; float q = 0.f;
#pragma unroll
                for (int bj = 0; bj < 2; ++bj) { const u32x4 b = xr[ai][m][bj];
                    const f32x4 x0 = {bf_lo(b[0]), bf_hi(b[0]), bf_lo(b[1]), bf_hi(b[1])}, x1 = {bf_lo(b[2]), bf_hi(b[2]), bf_lo(b[3]), bf_hi(b[3])};
                    const f32x4 v0 = x0 + acc[ai][bj][m][0], v1 = x1 + acc[ai][bj][m][1];
                    q += (v0[0] * v0[0] + v0[1] * v0[1]) + (v0[2] * v0[2] + v0[3] * v0[3]) + (v1[0] * v1[0] + v1[1] * v1[1]) + (v1[2] * v1[2] + v1[3] * v1[3]);
                    u32x4 w; w.x = cvt_pk_bf16(v0[0], v0[1]); w.y = cvt_pk_bf16(v0[2], v0[3]); w.z = cvt_pk_bf16(v1[0], v1[1]); w.w = cvt_pk_bf16(v1[2], v1[3]);
                    *(u32x4*)(ob + off + bj * HALF) = w; }
                q += __shfl_xor(q, 16); q += __shfl_xor(q, 32); sq[m] = q; }
            if (fq == 0) {
#pragma unroll
                for (int m = 0; m < 4; ++m) unsafeAtomicAdd(ss + row0 + ai * HALF + m * 16, sq[m]); } }
    }
};
template <class Epi, class Sched, bool ALIGN_EPI = false, bool SP2 = false, bool FP8 = false, int WSCALE = 0x7f7f7f7f>
__device__ __forceinline__ void gemm_phase(PG8_LAS unsigned char* lds, const Gemm g, const Sched& S, const Epi& E) {
    const int tid = otid(), wid = __builtin_amdgcn_readfirstlane(tid >> 6), lane = tid & 63, wr = wid >> 2, wc = wid & 3, fr = lane & 15, fq = lane >> 4;
    const int K = g.K, nt = K / BK;
    unsigned voffA[2], voffB[2];
#pragma unroll
    for (int i = 0; i < 2; ++i) { int R, C; stage_rc(tid * 16 + i * 8192, R, C); const int Rb = Epi::PERM ? ((R & ~31) + perm32(R & 31)) : R;
        voffA[i] = (unsigned)(R * K + C) * 2u; voffB[i] = (unsigned)(Rb * K + C) * 2u; }
    const unsigned kstep = (unsigned)(BK * 2);
    const unsigned hstep = (unsigned)HALF * K * 2;
    const unsigned tstep = 2 * hstep;
    const __amdgpu_buffer_rsrc_t rs_voffA = __builtin_amdgcn_make_buffer_rsrc((void*)g.A, 0, -1, 0x00020000), rs_voffB = __builtin_amdgcn_make_buffer_rsrc((void*)g.Bt, 0, -1, 0x00020000);
    const unsigned ldsw = (unsigned)wid * 1024u;
    const int aoff = lds_byte(wr * 64 + fr, fq * 8), boff = lds_byte(wc * 32 + fr, fq * 8);
#define PG8_SA(b, h) (((b) * 2 + (h)) * HTB)
#define PG8_SB(b, h) ((4 + (b) * 2 + (h)) * HTB)
#define PG8_STAGE(bufoff, gbase, voff) do { _Pragma("unroll") for (int _i = 0; _i < 2; ++_i) \
        __builtin_amdgcn_raw_ptr_buffer_load_lds(rs_##voff, (PG8_LAS void*)(lds + (bufoff) + ldsw + _i * 8192), 16, (int)(voff)[_i], (int)(gbase), 0, 0); } while (0)
#define PG8_LD32(p) ({ const v4i_t lo_ = *(const PG8_LAS v4i_t*)(p), hi_ = *(const PG8_LAS v4i_t*)((p) + 1024); (v8i_t){lo_[0], lo_[1], lo_[2], lo_[3], hi_[0], hi_[1], hi_[2], hi_[3]}; })
#define PG8_LDA(dst, b, h) do { _Pragma("unroll") for (int m = 0; m < 4; ++m) dst[m] = PG8_LD32(lds + PG8_SA(b, h) + aoff + m * 2048); } while (0)
#define PG8_LDB(dst, b, h) do { _Pragma("unroll") for (int n = 0; n < 2; ++n) dst[n] = PG8_LD32(lds + PG8_SB(b, h) + boff + n * 2048); } while (0)
#define PG8_H(x, k) (bf16x8)__builtin_bit_cast(bf16x8, (v4i_t){x[4 * (k)], x[4 * (k) + 1], x[4 * (k) + 2], x[4 * (k) + 3]})
#define PG8_MMA(ai, bj, At, Bt) do { __builtin_amdgcn_s_setprio(1); if constexpr (FP8) { _Pragma("unroll") for (int m = 0; m < 4; ++m) _Pragma("unroll") for (int n = 0; n < 2; ++n) \
        asm volatile("v_mfma_f32_16x16x128_f8f6f4 %0, %1, %2, %0" : "+v"(acc[ai][bj][m][n]) : "v"(Bt[n]), "v"(At[m])); } else { \
        _Pragma("unroll") for (int k = 0; k < 2; ++k) _Pragma("unroll") for (int m = 0; m < 4; ++m) _Pragma("unroll") for (int n = 0; n < 2; ++n) \
        acc[ai][bj][m][n] = __builtin_amdgcn_mfma_f32_16x16x32_bf16(PG8_H(Bt[n], k), PG8_H(At[m], k), acc[ai][bj][m][n], 0, 0, 0); } __builtin_amdgcn_s_setprio(0); } while (0)
#define PG8_WAIT_V(n) asm volatile("s_waitcnt vmcnt(" #n ")" ::: "memory")
#define PG8_WAIT_L(n) asm volatile("s_waitcnt lgkmcnt(" #n ")" ::: "memory")
#define PG8_BAR __builtin_amdgcn_s_barrier()
#define PG8_SCHED __builtin_amdgcn_sched_barrier(0)
    Unit cur, nxt; int ui = 0;
    if (!S.next(0, cur)) return;
    f32x4 acc[2][2][4][2];
#pragma unroll
    for (int a = 0; a < 2; ++a)
#pragma unroll
        for (int b = 0; b < 2; ++b)
#pragma unroll
            for (int m = 0; m < 4; ++m)
#pragma unroll
                for (int n = 0; n < 2; ++n) acc[a][b][m][n] = (f32x4){0.f, 0.f, 0.f, 0.f};
    v8i_t At[4], B0[2], B1[2];
    unsigned cA = __builtin_amdgcn_readfirstlane((unsigned)cur.pm * tstep), cB = __builtin_amdgcn_readfirstlane((unsigned)cur.pn * tstep);
    S.a_ready(cur);
    if constexpr (SP2) {
        PG8_STAGE(PG8_SB(0, 0), cB, voffB); PG8_STAGE(PG8_SB(0, 1), cB + hstep, voffB); PG8_STAGE(PG8_SA(0, 0), cA, voffA); PG8_STAGE(PG8_SA(0, 1), cA + hstep, voffA);
        if (wr == 1) PG8_BAR;
        PG8_WAIT_V(2); PG8_BAR;
        PG8_STAGE(PG8_SB(1, 0), cB + kstep, voffB); PG8_STAGE(PG8_SA(1, 0), cA + kstep, voffA); PG8_STAGE(PG8_SB(1, 1), cB + hstep + kstep, voffB);
        PG8_WAIT_V(6); PG8_BAR;
    } else {
        PG8_STAGE(PG8_SB(0, 0), cB, voffB); PG8_STAGE(PG8_SA(0, 0), cA, voffA); PG8_STAGE(PG8_SB(0, 1), cB + hstep, voffB); PG8_STAGE(PG8_SA(0, 1), cA + hstep, voffA);
        if (wr == 1) PG8_BAR;
        PG8_WAIT_V(4); PG8_BAR;
        PG8_STAGE(PG8_SB(1, 0), cB + kstep, voffB); PG8_STAGE(PG8_SA(1, 0), cA + kstep, voffA); PG8_STAGE(PG8_SB(1, 1), cB + hstep + kstep, voffB);
        PG8_WAIT_V(6); PG8_BAR;
    }
    for (;;) {
        const bool has_next = S.next(ui + 1, nxt);
        const unsigned nA = has_next ? __builtin_amdgcn_readfirstlane((unsigned)nxt.pm * tstep) : cA, nB = has_next ? __builtin_amdgcn_readfirstlane((unsigned)nxt.pn * tstep) : cB;
        for (int t = 0; t < nt; t += 2) {
            const bool last = (t == nt - 2);
            const unsigned a1 = cA + (unsigned)(t + 1) * kstep;
            const unsigned a2 = last ? nA : cA + (unsigned)(t + 2) * kstep, b2 = last ? nB : cB + (unsigned)(t + 2) * kstep;
            const unsigned a3 = a2 + kstep, b3 = b2 + kstep;
            if (last && has_next) S.a_ready(nxt);
            if constexpr (Epi::HAS_MID) { if (t == Epi::MID_T) { E.mid(acc, cur, wr, wc, fr, fq); PG8_WAIT_V(0); } }
            if constexpr (SP2) {
            PG8_LDB(B0, 0, 0); PG8_LDB(B1, 0, 1); PG8_SCHED; PG8_LDA(At, 0, 0); PG8_STAGE(PG8_SA(1, 1), a1 + hstep, voffA);
            PG8_WAIT_V(8); PG8_WAIT_L(0); PG8_BAR; PG8_MMA(0, 0, At, B0); PG8_MMA(0, 1, At, B1); PG8_BAR; PG8_SCHED;
            PG8_LDA(At, 0, 1); PG8_STAGE(PG8_SB(0, 0), b2, voffB); PG8_STAGE(PG8_SB(0, 1), b2 + hstep, voffB); PG8_STAGE(PG8_SA(0, 0), a2, voffA);
            PG8_WAIT_V(8); PG8_WAIT_L(0); PG8_BAR; PG8_MMA(1, 0, At, B0); PG8_MMA(1, 1, At, B1); PG8_BAR; PG8_SCHED;
            PG8_LDB(B0, 1, 0); PG8_LDB(B1, 1, 1); PG8_SCHED; PG8_LDA(At, 1, 0); PG8_STAGE(PG8_SA(0, 1), a2 + hstep, voffA);
            PG8_WAIT_V(8); PG8_WAIT_L(0); PG8_BAR; PG8_MMA(0, 0, At, B0); PG8_MMA(0, 1, At, B1); PG8_BAR; PG8_SCHED;
            PG8_LDA(At, 1, 1); PG8_STAGE(PG8_SB(1, 0), b3, voffB); PG8_STAGE(PG8_SB(1, 1), b3 + hstep, voffB); PG8_STAGE(PG8_SA(1, 0), a3, voffA);
            PG8_WAIT_V(8); PG8_WAIT_L(0); PG8_BAR; PG8_MMA(1, 0, At, B0); PG8_MMA(1, 1, At, B1); PG8_BAR; PG8_SCHED;
            } else {
            PG8_LDB(B0, 0, 0); PG8_SCHED; PG8_LDA(At, 0, 0); PG8_STAGE(PG8_SA(1, 1), a1 + hstep, voffA);
            PG8_WAIT_L(8); PG8_BAR; PG8_WAIT_L(0); PG8_MMA(0, 0, At, B0); PG8_BAR; PG8_SCHED;
            PG8_LDB(B1, 0, 1); PG8_STAGE(PG8_SB(0, 0), b2, voffB);
            PG8_BAR; PG8_WAIT_L(0); PG8_MMA(0, 1, At, B1); PG8_BAR;
            PG8_LDA(At, 0, 1); PG8_STAGE(PG8_SA(0, 0), a2, voffA);
            PG8_BAR; PG8_WAIT_L(0); PG8_MMA(1, 0, At, B0); PG8_BAR; PG8_SCHED;
            PG8_STAGE(PG8_SB(0, 1), b2 + hstep, voffB);
            PG8_WAIT_V(6); PG8_BAR; PG8_MMA(1, 1, At, B1); PG8_BAR;
            PG8_LDB(B0, 1, 0); PG8_SCHED; PG8_LDA(At, 1, 0); PG8_STAGE(PG8_SA(0, 1), a2 + hstep, voffA);
            PG8_WAIT_L(8); PG8_BAR; PG8_WAIT_L(0); PG8_MMA(0, 0, At, B0); PG8_BAR; PG8_SCHED;
            PG8_LDB(B1, 1, 1); PG8_STAGE(PG8_SB(1, 0), b3, voffB);
            PG8_BAR; PG8_WAIT_L(0); PG8_MMA(0, 1, At, B1); PG8_BAR;
            PG8_LDA(At, 1, 1); PG8_STAGE(PG8_SA(1, 0), a3, voffA);
            PG8_BAR; PG8_WAIT_L(0); PG8_MMA(1, 0, At, B0); PG8_BAR; PG8_SCHED;
            PG8_STAGE(PG8_SB(1, 1), b3 + hstep, voffB);
            PG8_WAIT_V(6); PG8_BAR; PG8_MMA(1, 1, At, B1); PG8_BAR;
            }
        }
        if constexpr (FP8) { asm volatile("s_nop 15\n\ts_nop 15\n\ts_nop 15\n\ts_nop 15" ::: "memory"); }
        if constexpr (ALIGN_EPI) { if (wr == 0) PG8_BAR; }
        if constexpr (!Epi::AFTER_DRAIN) { E(acc, cur, wr, wc, fr, fq); S.done(cur); }
        if (!has_next) break;
#pragma unroll
        for (int a = 0; a < 2; ++a)
#pragma unroll
            for (int b = 0; b < 2; ++b)
#pragma unroll
                for (int m = 0; m < 4; ++m)
#pragma unroll
                    for (int n = 0; n < 2; ++n) acc[a][b][m][n] = (f32x4){0.f, 0.f, 0.f, 0.f};
        cur = nxt; cA = nA; cB = nB; ++ui;
        if constexpr (ALIGN_EPI) { if (wr == 1) PG8_BAR; }
    }
    PG8_WAIT_V(0);
    if constexpr (!ALIGN_EPI) { if (wr == 0) PG8_BAR; }
    PG8_BAR;
    if constexpr (Epi::AFTER_DRAIN) { E.fused(acc, cur, wr, wc, fr, fq, lds, wid, lane); S.done(cur); }
#undef PG8_SA
#undef PG8_SB
#undef PG8_STAGE
#undef PG8_LDA
#undef PG8_LDB
#undef PG8_MMA
#undef PG8_LD32
#undef PG8_H
#undef PG8_WAIT_V
#undef PG8_WAIT_L
#undef PG8_BAR
#undef PG8_SCHED
}
}


constexpr int DM = 2048, SEQ = 16384, NSEQ = 3, HD = 128, DFF = 8192, INW = 11264;
constexpr int C_AQ = 0, C_AK = 1536, C_AV = 3072, C_BQ = 4608, C_BK = 6144, C_BV = 6656, C_GA = 7168, C_GB = 9216;
constexpr float RMS_EPS = 1e-6f;
constexpr float LOG2E = 1.4426950408889634f, LN2 = 0.6931471805599453f;

namespace att {
typedef unsigned short bf16;
constexpr int D = 128, NW = 8, QBLK = 32, KVBLK = 64;
constexpr float SCALE = 0.088388347648318440f;
constexpr float THR = 8.f;
constexpr int SHM_V = KVBLK * D * 2, SHM_K = KVBLK * D * 2, SHM_ATTN = 2 * SHM_V + 2 * SHM_K + NW * 64 * 4;
using bf16x8 = __attribute__((ext_vector_type(8))) short;
using s16x4  = __attribute__((ext_vector_type(4))) short;
using f32x16 = __attribute__((ext_vector_type(16))) float;
using u32x4  = __attribute__((ext_vector_type(4))) unsigned;
#define KSWZ(row, colB) ((row) * 256 + ((colB) ^ (((row) & 7) << 4)))
#define SBAR() __builtin_amdgcn_sched_barrier(0)
__device__ __forceinline__ int crow(int r, int hi) { return (r & 3) + 8 * (r >> 2) + 4 * hi; }
__device__ __forceinline__ unsigned cvtpk(float lo, float hi) { unsigned r; asm volatile("v_cvt_pk_bf16_f32 %0, %1, %2" : "=v"(r) : "v"(lo), "v"(hi)); return r; }
__device__ __forceinline__ bf16x8 ld8(const bf16* p) { return *reinterpret_cast<const bf16x8*>(p); }

__device__ __forceinline__ void partialSM(f32x16& p0, f32x16& p1, float& m_reg, float& mn, float& alpha) {
  constexpr float C = SCALE * 1.4426950408889634f;
  float pmax = p0[0]; for (int r = 1; r < 16; ++r) pmax = fmaxf(pmax, p0[r]); for (int r = 0; r < 16; ++r) pmax = fmaxf(pmax, p1[r]);
  { auto rr = __builtin_amdgcn_permlane32_swap(__float_as_uint(pmax), __float_as_uint(pmax), false, false);
    pmax = fmaxf(__uint_as_float(rr[0]), __uint_as_float(rr[1])); }
  if (__builtin_expect(__all(pmax - m_reg <= THR / SCALE), 1)) { mn = m_reg; alpha = 1.f; }
  else { mn = fmaxf(m_reg, pmax); alpha = __builtin_amdgcn_exp2f((m_reg - mn) * C); m_reg = mn; }
  float mnC = -mn * C;
  for (int r = 0; r < 16; ++r) p0[r] = fmaf(p0[r], C, mnC); for (int r = 0; r < 16; ++r) p1[r] = fmaf(p1[r], C, mnC);
  for (int r = 0; r < 16; ++r) p0[r] = __builtin_amdgcn_exp2f(p0[r]);
}
#define PK4(P, BASE, OUT) do { unsigned a0 = cvtpk(P[BASE + 0], P[BASE + 1]), a1 = cvtpk(P[BASE + 2], P[BASE + 3]);   \
    unsigned b0 = cvtpk(P[BASE + 4], P[BASE + 5]), b1 = cvtpk(P[BASE + 6], P[BASE + 7]);                              \
    auto r0 = __builtin_amdgcn_permlane32_swap(a0, b0, false, false); auto r1 = __builtin_amdgcn_permlane32_swap(a1, b1, false, false); \
    u32x4 w = {r0[0], r1[0], r0[1], r1[1]}; OUT = *reinterpret_cast<bf16x8*>(&w); } while (0)
__device__ __forceinline__ void finishSM(f32x16& p0, f32x16& p1, float alpha, float& l_reg, bf16x8& pa0, bf16x8& pa1, bf16x8& pa2, bf16x8& pa3) {
  for (int r = 0; r < 16; ++r) p1[r] = __builtin_amdgcn_exp2f(p1[r]);
  float ps = 0; for (int r = 0; r < 16; ++r) ps += p0[r]; for (int r = 0; r < 16; ++r) ps += p1[r];
  { auto rr = __builtin_amdgcn_permlane32_swap(__float_as_uint(ps), __float_as_uint(ps), false, false);
    ps = __uint_as_float(rr[0]) + __uint_as_float(rr[1]); }
  l_reg = l_reg * alpha + ps;
  PK4(p0, 0, pa0); PK4(p0, 8, pa1); PK4(p1, 0, pa2); PK4(p1, 8, pa3);
}
__device__ __forceinline__ void qkt(f32x16& p0, f32x16& p1, const bf16* Ks, const bf16x8* qr, int r32, int hi) {
  p0 = f32x16{}; p1 = f32x16{};
  for (int d0 = 0; d0 < 8; ++d0) { int cb = (d0 * 16 + hi * 8) * 2;
    bf16x8 b0 = *reinterpret_cast<const bf16x8*>((const char*)Ks + KSWZ(r32, cb));
    bf16x8 b1 = *reinterpret_cast<const bf16x8*>((const char*)Ks + KSWZ(32 + r32, cb));
    p0 = __builtin_amdgcn_mfma_f32_32x32x16_bf16(b0, qr[d0], p0, 0, 0, 0);
    p1 = __builtin_amdgcn_mfma_f32_32x32x16_bf16(b1, qr[d0], p1, 0, 0, 0); }
}
__device__ __forceinline__ int v_st(int k, int c) { const int kk = (k & ~0xC) | ((k & 4) << 1) | ((k & 8) >> 1); return ((kk >> 3) * 4 + (c >> 5)) * 512 + ((kk & 7) * 32 + (c & 31)) * 2; }
__device__ __forceinline__ int v_rd_base(int lane) { return ((lane & 3) << 3) | (((lane >> 2) & 3) << 6) | (((lane >> 4) & 1) << 5) | (((lane >> 5) & 1) << 8); }
constexpr int v_rd_off(int d0, int ks, int half) { return d0 * 512 + ks * 4096 + half * 2048; }
template <int OFF> __device__ __forceinline__ s16x4 tr_read(int vb) {
  s16x4 r; asm volatile("ds_read_b64_tr_b16 %0, %1 offset:%2" : "=&v"(r) : "v"(vb), "i"(OFF) : "memory"); return r;
}
template <int D0> __device__ __forceinline__ void pv_one(f32x16& od, int vb, bf16x8 pa0, bf16x8 pa1, bf16x8 pa2, bf16x8 pa3) {
  const s16x4 l0 = tr_read<v_rd_off(D0, 0, 0)>(vb), h0 = tr_read<v_rd_off(D0, 0, 1)>(vb), l1 = tr_read<v_rd_off(D0, 1, 0)>(vb), h1 = tr_read<v_rd_off(D0, 1, 1)>(vb);
  const s16x4 l2 = tr_read<v_rd_off(D0, 2, 0)>(vb), h2 = tr_read<v_rd_off(D0, 2, 1)>(vb), l3 = tr_read<v_rd_off(D0, 3, 0)>(vb), h3 = tr_read<v_rd_off(D0, 3, 1)>(vb);
  asm volatile("s_waitcnt lgkmcnt(0)" ::: "memory"); SBAR();
#define PK(L, H) (bf16x8){L[0], L[1], L[2], L[3], H[0], H[1], H[2], H[3]}
  od = __builtin_amdgcn_mfma_f32_32x32x16_bf16(pa0, PK(l0, h0), od, 0, 0, 0);
  od = __builtin_amdgcn_mfma_f32_32x32x16_bf16(pa1, PK(l1, h1), od, 0, 0, 0);
  od = __builtin_amdgcn_mfma_f32_32x32x16_bf16(pa2, PK(l2, h2), od, 0, 0, 0);
  od = __builtin_amdgcn_mfma_f32_32x32x16_bf16(pa3, PK(l3, h3), od, 0, 0, 0);
#undef PK
}
__device__ __forceinline__ void pv_d0(f32x16* o, int vb, bf16x8 pa0, bf16x8 pa1, bf16x8 pa2, bf16x8 pa3) {
  pv_one<0>(o[0], vb, pa0, pa1, pa2, pa3); pv_one<1>(o[1], vb, pa0, pa1, pa2, pa3); pv_one<2>(o[2], vb, pa0, pa1, pa2, pa3); pv_one<3>(o[3], vb, pa0, pa1, pa2, pa3);
}

template <int LDQ, int LDK, int LDO>
__device__ __forceinline__ void attn_dense_body(const bf16* __restrict__ Qb, const bf16* __restrict__ Kh, const bf16* __restrict__ Vh, bf16* __restrict__ Ob, int seq, char* lds) {
  constexpr int SDEPTH = 2;
  const int tid = pg8::otid(), wid = tid >> 6, lane = tid & 63, r32 = lane & 31, hi = lane >> 5;
  bf16* V_lds = (bf16*)lds; bf16* K_lds = (bf16*)(lds + 2 * SHM_V);
  float* ws = (float*)(lds + 2 * SHM_V + 2 * SHM_K) + wid * 64; float* li_l = ws; float* al_l = ws + 32;
  float m_reg = -1e30f, l_reg = 0; f32x16 o[4] = {}; bf16x8 qr[8];
  const bf16* Qw = Qb + (long)(wid * QBLK + r32) * LDQ + hi * 8;
#pragma unroll
  for (int d0 = 0; d0 < 8; ++d0) qr[d0] = ld8(Qw + d0 * 16);
  const int sr = tid >> 4, sc = (tid & 15) * 8, vst0 = v_st(sr, sc), vst1 = v_st(32 + sr, sc);
  const int vb0 = (int)(uintptr_t)V_lds + v_rd_base(lane);
  struct { bf16x8 vs0, vs1, ks0, ks1; } sr_[SDEPTH];
#define SLOAD(i, k0) do { sr_[i].vs0 = ld8(&Vh[(long)((k0) + sr) * LDK + sc]); sr_[i].vs1 = ld8(&Vh[(long)((k0) + 32 + sr) * LDK + sc]); \
    sr_[i].ks0 = ld8(&Kh[(long)((k0) + sr) * LDK + sc]); sr_[i].ks1 = ld8(&Kh[(long)((k0) + 32 + sr) * LDK + sc]); } while (0)
#define SWRITE(b, i) do { *(bf16x8*)((char*)V_lds + (b) * SHM_V + vst0) = sr_[i].vs0;          \
    *(bf16x8*)((char*)V_lds + (b) * SHM_V + vst1) = sr_[i].vs1; int kc = sc * 2;               \
    *(bf16x8*)((char*)K_lds + (b) * SHM_K + KSWZ(sr, kc)) = sr_[i].ks0;                       \
    *(bf16x8*)((char*)K_lds + (b) * SHM_K + KSWZ(32 + sr, kc)) = sr_[i].ks1; } while (0)
#define SWAIT() asm volatile("s_waitcnt vmcnt(4)" ::: "memory")
#define RESC(a) do { if (__any((a) < 1.f)) { if (hi == 0) al_l[r32] = (a); asm volatile("s_waitcnt lgkmcnt(0)" ::: "memory"); \
    for (int d = 0; d < 4; ++d) for (int r = 0; r < 16; ++r) o[d][r] *= al_l[crow(r, hi)]; } } while (0)
  f32x16 pA0, pA1, pB0, pB1; float mnA, mnB, alA, alB; bf16x8 pa0, pa1, pa2, pa3; const int NT = seq / KVBLK;
  constexpr int SE = 0, SO = SDEPTH - 1;
  SLOAD(SE, 0); asm volatile("s_waitcnt vmcnt(0)" ::: "memory"); SWRITE(0, SE); __syncthreads();
  qkt(pA0, pA1, K_lds, qr, r32, hi); partialSM(pA0, pA1, m_reg, mnA, alA);
  SLOAD(SO, KVBLK); if (2 < NT) SLOAD(SE, 2 * KVBLK);
  SWAIT(); SWRITE(1, SO); __syncthreads();
  for (int j = 1; j + 1 < NT; j += 2) {
    SBAR(); qkt(pB0, pB1, (bf16*)((char*)K_lds + SHM_K), qr, r32, hi);
    finishSM(pA0, pA1, alA, l_reg, pa0, pa1, pa2, pa3); SBAR();
    SLOAD(SO, (j + SDEPTH) * KVBLK); SBAR();
    pv_d0(o, vb0, pa0, pa1, pa2, pa3); partialSM(pB0, pB1, m_reg, mnB, alB);
    __syncthreads(); SWAIT(); SWRITE(0, SE);
    RESC(alB); __syncthreads();
    SBAR(); qkt(pA0, pA1, K_lds, qr, r32, hi);
    finishSM(pB0, pB1, alB, l_reg, pa0, pa1, pa2, pa3); SBAR();
    if (j + 3 < NT) SLOAD(SE, (j + 1 + SDEPTH) * KVBLK); SBAR();
    pv_d0(o, vb0 + (int)SHM_V, pa0, pa1, pa2, pa3); partialSM(pA0, pA1, m_reg, mnA, alA);
    __syncthreads(); SWAIT(); SWRITE(1, SO);
    RESC(alA); __syncthreads();
  }
  SBAR(); qkt(pB0, pB1, (bf16*)((char*)K_lds + SHM_K), qr, r32, hi);
  finishSM(pA0, pA1, alA, l_reg, pa0, pa1, pa2, pa3); SBAR();
  pv_d0(o, vb0, pa0, pa1, pa2, pa3); partialSM(pB0, pB1, m_reg, mnB, alB);
  __syncthreads(); RESC(alB);
  finishSM(pB0, pB1, alB, l_reg, pa0, pa1, pa2, pa3); SBAR();
  pv_d0(o, vb0 + (int)SHM_V, pa0, pa1, pa2, pa3);
  if (hi == 0) li_l[r32] = l_reg; asm volatile("s_waitcnt lgkmcnt(0)" ::: "memory");
  float rli[16];
#pragma unroll
  for (int r = 0; r < 16; ++r) rli[r] = __builtin_amdgcn_rcpf(li_l[crow(r, hi)]);
  bf16* Ow = Ob + (long)(wid * QBLK) * LDO;
#pragma unroll
  for (int r = 0; r < 16; ++r) { int orow = crow(r, hi);
#pragma unroll
    for (int d0 = 0; d0 < 4; ++d0) { const float v = o[d0][r] * rli[r]; Ow[(long)orow * LDO + d0 * 32 + r32] = (bf16)(cvtpk(v, v) & 0xffffu); } }
#undef SLOAD
#undef SWRITE
#undef SWAIT
}

__device__ __forceinline__ void dil_unit(const bf16* __restrict__ proj, bf16* __restrict__ og, float* __restrict__ lse, int g, int h, int res, int q0, char* lds) {
  const int d = (g == 0) ? 1 : (g == 1 ? 4 : 16), L = SEQ / d;
  const int tid = pg8::otid(), wid = tid >> 6, lane = tid & 63, r32 = lane & 31, hi = lane >> 5;
  bf16* V_lds = (bf16*)lds; bf16* K_lds = (bf16*)(lds + 2 * SHM_V);
  float* ws = (float*)(lds + 2 * SHM_V + 2 * SHM_K) + wid * 64; float* li_l = ws; float* al_l = ws + 32;
  const int colb = g * 512 + h * 128;
  const float slope = exp2f(-8.0f * (float)(g * 4 + h + 1) / 12.0f);
  const float sl2 = slope * (float)d * LOG2E;
  constexpr float C = SCALE * LOG2E;
  float m_reg = -1e30f, l_reg = 0; f32x16 o[4] = {}; bf16x8 qr[8];
  const int wq0 = q0 + wid * QBLK, qj = wq0 + r32;
  { const bf16* Qw = proj + (size_t)((size_t)qj * d + res) * INW + C_AQ + colb + hi * 8;
#pragma unroll
    for (int d0 = 0; d0 < 8; ++d0) qr[d0] = ld8(Qw + d0 * 16); }
  const int sr = tid >> 4, sc = (tid & 15) * 8, vst0 = v_st(sr, sc), vst1 = v_st(32 + sr, sc);
  const int vb0 = (int)(uintptr_t)V_lds + v_rd_base(lane);
  bf16x8 vs0, vs1, ks0, ks1;
#define DLOAD(kt) do { int ka = q0 - 64 + 64 * (kt) + sr, kb = ka + 32; ka = ka < 0 ? 0 : (ka > L - 1 ? L - 1 : ka); kb = kb < 0 ? 0 : (kb > L - 1 ? L - 1 : kb); \
    const bf16* pa_ = proj + (size_t)((size_t)ka * d + res) * INW + colb + sc; const bf16* pb_ = proj + (size_t)((size_t)kb * d + res) * INW + colb + sc; \
    vs0 = ld8(pa_ + C_AV); vs1 = ld8(pb_ + C_AV); ks0 = ld8(pa_ + C_AK); ks1 = ld8(pb_ + C_AK); } while (0)
#define DWRITE(b) do { *(bf16x8*)((char*)V_lds + (b) * SHM_V + vst0) = vs0; *(bf16x8*)((char*)V_lds + (b) * SHM_V + vst1) = vs1; const int kc = sc * 2; \
    *(bf16x8*)((char*)K_lds + (b) * SHM_K + KSWZ(sr, kc)) = ks0; *(bf16x8*)((char*)K_lds + (b) * SHM_K + KSWZ(32 + sr, kc)) = ks1; } while (0)
  DLOAD(0);
  const int kt_lo = wid >> 1;
  for (int kt = 0; kt < 6; ++kt) {
    const int b = kt & 1;
    asm volatile("s_waitcnt vmcnt(0)" ::: "memory"); DWRITE(b);
    if (kt + 1 < 6) DLOAD(kt + 1);
    __syncthreads();
    if (kt >= kt_lo && kt <= kt_lo + 2) {
      f32x16 p0, p1;
      qkt(p0, p1, (const bf16*)((const char*)K_lds + b * SHM_K), qr, r32, hi);
      const int k0 = q0 - 64 + 64 * kt;
      float pmax = -INFINITY;
      if (k0 >= 0 && k0 + 64 <= L) {
        const float fd = (float)(k0 - qj + 4 * hi);
#pragma unroll
        for (int r = 0; r < 16; ++r) { const float a0 = fabsf(fd + (float)((r & 3) + 8 * (r >> 2))), a1 = fabsf(fd + (float)((r & 3) + 8 * (r >> 2) + 32));
          p0[r] = (a0 <= 64.f) ? fmaf(p0[r], C, -sl2 * a0) : -INFINITY; p1[r] = (a1 <= 64.f) ? fmaf(p1[r], C, -sl2 * a1) : -INFINITY;
          pmax = fmaxf(pmax, fmaxf(p0[r], p1[r])); }
      } else {
#pragma unroll
      for (int r = 0; r < 16; ++r) {
        const int kj0 = k0 + crow(r, hi), kj1 = kj0 + 32; const int a0 = abs(kj0 - qj), a1 = abs(kj1 - qj);
        const bool v0 = (a0 <= 64) && (kj0 >= 0) && (kj0 < L), v1 = (a1 <= 64) && (kj1 >= 0) && (kj1 < L);
        p0[r] = v0 ? fmaf(p0[r], C, -sl2 * (float)a0) : -INFINITY; p1[r] = v1 ? fmaf(p1[r], C, -sl2 * (float)a1) : -INFINITY;
        pmax = fmaxf(pmax, fmaxf(p0[r], p1[r])); }
      }
      { auto rr = __builtin_amdgcn_permlane32_swap(__float_as_uint(pmax), __float_as_uint(pmax), false, false);
        pmax = fmaxf(__uint_as_float(rr[0]), __uint_as_float(rr[1])); }
      const float mn = fmaxf(m_reg, pmax); const float alpha = __builtin_amdgcn_exp2f(m_reg - mn); m_reg = mn;
      float ps = 0.f;
#pragma unroll
      for (int r = 0; r < 16; ++r) { p0[r] = __builtin_amdgcn_exp2f(p0[r] - mn); p1[r] = __builtin_amdgcn_exp2f(p1[r] - mn); ps += p0[r] + p1[r]; }
      { auto rr = __builtin_amdgcn_permlane32_swap(__float_as_uint(ps), __float_as_uint(ps), false, false);
        ps = __uint_as_float(rr[0]) + __uint_as_float(rr[1]); }
      l_reg = l_reg * alpha + ps;
      RESC(alpha);
      bf16x8 pa0, pa1, pa2, pa3;
      PK4(p0, 0, pa0); PK4(p0, 8, pa1); PK4(p1, 0, pa2); PK4(p1, 8, pa3);
      pv_d0(o, vb0 + b * (int)SHM_V, pa0, pa1, pa2, pa3);
    }
  }
  if (hi == 0) { li_l[r32] = l_reg; lse[(size_t)((size_t)qj * d + res) * 12 + g * 4 + h] = (m_reg + __log2f(l_reg)) * LN2; }
  asm volatile("s_waitcnt lgkmcnt(0)" ::: "memory");
  const bool odd = (r32 & 1) != 0;
#pragma unroll
  for (int rp = 0; rp < 16; rp += 2) { const float rle = __builtin_amdgcn_rcpf(li_l[crow(rp, hi)]), rlo = __builtin_amdgcn_rcpf(li_l[crow(rp + 1, hi)]);
    const int orow = crow(rp + (odd ? 1 : 0), hi);
    unsigned* Ow = (unsigned*)(og + (size_t)((size_t)(wq0 + orow) * d + res) * 1536 + colb + (r32 & ~1));
#pragma unroll
    for (int d0 = 0; d0 < 4; ++d0) { const float ve = o[d0][rp] * rle, vo = o[d0][rp + 1] * rlo;
      const float mine = odd ? vo : ve, give = odd ? ve : vo;
      const float got = __uint_as_float(__builtin_amdgcn_mov_dpp(__float_as_uint(give), 0xB1, 0xF, 0xF, true));
      Ow[d0 * 16] = odd ? cvtpk(got, mine) : cvtpk(mine, got); } }
  __syncthreads();
#undef DLOAD
#undef DWRITE
}
#undef RESC
#undef PK4
#undef KSWZ
#undef SBAR
}


namespace att8 {
typedef int v8i __attribute__((ext_vector_type(8)));
typedef int v4i __attribute__((ext_vector_type(4)));
using att::f32x16; using att::crow;
constexpr int TILE_B = 8192, NSLOT = 4;
constexpr int LDS_K = 0, LDS_V = NSLOT * TILE_B, LDS_WS = 2 * NSLOT * TILE_B, LDS_BYTES8 = LDS_WS + 8 * 256;
constexpr float THR2 = 5.0f;
constexpr float PSH = 3.0f;
constexpr int SC_ONE = 0, SC_Q = 0;
#define A8_LAS __attribute__((address_space(3)))
#define A8_WAIT_V(n) asm volatile("s_waitcnt vmcnt(" #n ")" ::: "memory")
#define A8_BAR() do { asm volatile("" ::: "memory"); __builtin_amdgcn_s_barrier(); asm volatile("" ::: "memory"); } while (0)
__device__ __forceinline__ v8i ld32(const A8_LAS unsigned char* p0, const A8_LAS unsigned char* p1) {
  const v4i a = *(const A8_LAS v4i*)p0, b = *(const A8_LAS v4i*)p1; return (v8i){a[0], a[1], a[2], a[3], b[0], b[1], b[2], b[3]};
}
__device__ __forceinline__ float max3f(float a, float b, float c) { return fmaxf(fmaxf(a, b), c); }
#define A8_SOFF ((f32x16){-4.f, -4.f, -4.f, -4.f, -4.f, -4.f, -4.f, -4.f, -4.f, -4.f, -4.f, -4.f, -4.f, -4.f, -4.f, -4.f})
__device__ __forceinline__ void qkt8(f32x16& p0, f32x16& p1, const A8_LAS unsigned char* ks, const int (&koff)[4], const v8i (&qf)[2]) {
  p0 = A8_SOFF; p1 = A8_SOFF;
#pragma unroll
  for (int kk = 0; kk < 2; ++kk) {
    const v8i a0 = ld32(ks + koff[2 * kk], ks + koff[2 * kk + 1]), a1 = ld32(ks + 4096 + koff[2 * kk], ks + 4096 + koff[2 * kk + 1]);
    p0 = __builtin_amdgcn_mfma_scale_f32_32x32x64_f8f6f4(a0, qf[kk], p0, 0, 0, 0, SC_ONE, 0, SC_Q);
    p1 = __builtin_amdgcn_mfma_scale_f32_32x32x64_f8f6f4(a1, qf[kk], p1, 0, 0, 0, SC_ONE, 0, SC_Q); }
}
__device__ __forceinline__ void partialSM8(f32x16& p0, f32x16& p1, float& m_reg, float& alpha, float& sc) {
  float pmax = max3f(p0[0], p0[1], p0[2]);
#pragma unroll
  for (int r = 3; r < 15; r += 2) pmax = max3f(pmax, p0[r], p0[r + 1]);
  pmax = fmaxf(pmax, p0[15]);
#pragma unroll
  for (int r = 0; r < 16; r += 2) pmax = max3f(pmax, p1[r], p1[r + 1]);
  { auto rr = __builtin_amdgcn_permlane32_swap(__float_as_uint(pmax), __float_as_uint(pmax), false, false);
    pmax = fmaxf(__uint_as_float(rr[0]), __uint_as_float(rr[1])); }
  alpha = 1.f;
  if (__builtin_expect(!__all(pmax - m_reg <= THR2), 0)) { const float mn = fmaxf(m_reg, __builtin_ceilf(pmax)); alpha = __builtin_amdgcn_exp2f(m_reg - mn); m_reg = mn; }
  sc = __builtin_amdgcn_exp2f(m_reg - PSH);
#pragma unroll
  for (int r = 0; r < 16; ++r) p0[r] = __builtin_amdgcn_exp2f(p0[r]);
}
typedef short v2s __attribute__((ext_vector_type(2)));
__device__ __forceinline__ int pk4_fp8(float a, float b, float c, float d, float sc) {
  v2s x = __builtin_amdgcn_cvt_scalef32_pk_fp8_f32((v2s){0, 0}, a, b, sc, false); x = __builtin_amdgcn_cvt_scalef32_pk_fp8_f32(x, c, d, sc, true); return __builtin_bit_cast(int, x);
}
__device__ __forceinline__ void finishSM8(const f32x16& p0, f32x16& p1, float sc, v8i& pf) {
#pragma unroll
  for (int r = 0; r < 16; ++r) p1[r] = __builtin_amdgcn_exp2f(p1[r]);
#pragma unroll
  for (int w = 0; w < 4; ++w) pf[w] = pk4_fp8(p0[4 * w], p0[4 * w + 1], p0[4 * w + 2], p0[4 * w + 3], sc);
#pragma unroll
  for (int w = 0; w < 4; ++w) pf[4 + w] = pk4_fp8(p1[4 * w], p1[4 * w + 1], p1[4 * w + 2], p1[4 * w + 3], sc);
}
typedef float f32x4_t __attribute__((ext_vector_type(4)));
#define A8_ROWSUM(ls, pf, bp) ls = __builtin_amdgcn_mfma_scale_f32_16x16x128_f8f6f4(pf, bp, ls, 1, 0, 0, 0, 0, 0)
__device__ __forceinline__ void pv8(f32x16 (&o)[4], f32x4_t& lsum, const v8i& bpat, const A8_LAS unsigned char* vs, const int (&voff)[2], const v8i& pf) {
#pragma unroll
  for (int d0 = 0; d0 < 4; ++d0) { const v8i b = ld32(vs + d0 * 2048 + voff[0], vs + d0 * 2048 + voff[1]);
    o[d0] = __builtin_amdgcn_mfma_scale_f32_32x32x64_f8f6f4(pf, b, o[d0], 1, 0, 0, SC_ONE, 0, SC_ONE); }
  A8_ROWSUM(lsum, pf, bpat);
}
constexpr int RING8 = 8, LDS_V8 = RING8 * TILE_B, LDS_WS8 = 2 * RING8 * TILE_B + 1024;
__device__ __forceinline__ int pk4_bf8(float a, float b, float c, float d) {
  const unsigned h0 = __builtin_bit_cast(unsigned, __builtin_amdgcn_cvt_pkrtz(a, b)), h1 = __builtin_bit_cast(unsigned, __builtin_amdgcn_cvt_pkrtz(c, d));
  return (int)__builtin_amdgcn_perm(h1, h0, 0x07050301u);
}
__device__ __forceinline__ void softmax8p(f32x16& p0, f32x16& p1, v8i& pf) {
#pragma unroll
  for (int r = 0; r < 16; ++r) { p0[r] = __builtin_amdgcn_exp2f(p0[r]); p1[r] = __builtin_amdgcn_exp2f(p1[r]); }
#pragma unroll
  for (int w = 0; w < 4; ++w) pf[w] = pk4_bf8(p0[4 * w], p0[4 * w + 1], p0[4 * w + 2], p0[4 * w + 3]);
#pragma unroll
  for (int w = 0; w < 4; ++w) pf[4 + w] = pk4_bf8(p1[4 * w], p1[4 * w + 1], p1[4 * w + 2], p1[4 * w + 3]);
}
template <int LDQ8, int LDO>
__device__ __forceinline__ void attn8_body(const unsigned char* __restrict__ Q8b, const unsigned char* __restrict__ Kimg, const unsigned char* __restrict__ Vimg,
                                           unsigned char* __restrict__ Ob, int NT, A8_LAS unsigned char* lds) {
  const int tid = pg8::otid(), wid = __builtin_amdgcn_readfirstlane(tid >> 6), lane = tid & 63, r32 = lane & 31, hi = lane >> 5;
  if (wid >= 4) __builtin_amdgcn_s_setprio(1);
  A8_LAS float* al_l = (A8_LAS float*)(lds + LDS_WS8) + wid * 64;
  v8i qf[2];
  { const unsigned char* qp = Q8b + (size_t)(wid * 32 + r32) * LDQ8 + 32 * hi;
#pragma unroll
    for (int kk = 0; kk < 2; ++kk) { const v4i a = *(const v4i*)(qp + 64 * kk), b = *(const v4i*)(qp + 64 * kk + 16); qf[kk] = (v8i){a[0], a[1], a[2], a[3], b[0], b[1], b[2], b[3]}; } }
  int koff[4], voff[2];
  { const int sK = (r32 >> 1) & 7, sV = (r32 >> 2) & 3;
#pragma unroll
    for (int kk = 0; kk < 2; ++kk)
#pragma unroll
      for (int e = 0; e < 2; ++e) koff[2 * kk + e] = r32 * 128 + (((4 * kk + 2 * hi + e) ^ sK) << 4);
#pragma unroll
    for (int e = 0; e < 2; ++e) voff[e] = LDS_V8 + r32 * 64 + (((2 * hi + e) ^ sV) << 4); }
  const unsigned goff = (unsigned)wid * 1024u + (unsigned)lane * 16u;
  A8_LAS unsigned char* kdst = lds + wid * 1024; A8_LAS unsigned char* vdst = lds + LDS_V8 + wid * 1024;
  const __amdgpu_buffer_rsrc_t krs = __builtin_amdgcn_make_buffer_rsrc((void*)Kimg, 0, NT * TILE_B, 0x00020000), vrs = __builtin_amdgcn_make_buffer_rsrc((void*)Vimg, 0, NT * TILE_B, 0x00020000);
#define A8_STAGE(t) do { const int t_ = (t) < NT ? (t) : NT - 1; const int sl_ = ((t) & 7) * TILE_B; \
    __builtin_amdgcn_raw_ptr_buffer_load_lds(krs, (A8_LAS void*)(kdst + sl_), 16, (int)goff, t_ * TILE_B, 0, 0); \
    __builtin_amdgcn_raw_ptr_buffer_load_lds(vrs, (A8_LAS void*)(vdst + sl_), 16, (int)goff, t_ * TILE_B, 0, 0); } while (0)
#define A8_RESC(a) do { if (__any((a) < 1.f)) { if (hi == 0) al_l[r32] = (a); asm volatile("s_waitcnt lgkmcnt(0)" ::: "memory"); \
    _Pragma("unroll") for (int r = 0; r < 16; ++r) { const float f_ = al_l[crow(r, hi)]; _Pragma("unroll") for (int d = 0; d < 4; ++d) o[d][r] *= f_; } \
    _Pragma("unroll") for (int i = 0; i < 4; ++i) lsum[i] *= al_l[lrow0 + i]; } } while (0)
#define A8_KS(t) (lds + ((t) & 7) * TILE_B)
#define A8_VS(t) (lds + ((t) & 7) * TILE_B)
#define A8_SYNC(t) do { A8_WAIT_V(2); A8_BAR(); } while (0)
  f32x16 o[4] = {}; f32x4_t lsum = {0.f, 0.f, 0.f, 0.f};
  f32x16 pA0, pA1, pB0, pB1; v8i pfA, pfB = {}, kf[4], vf[4], bpat;
  const int lrow0 = 4 * (lane >> 4) + (((lane & 15) >= 8) ? 16 : 0);
  { const int bv = ((((lane >> 4) & 1) != 0) == ((lane & 15) >= 8)) ? 0x38383838 : 0;
    bpat = (v8i){bv, bv, bv, bv, bv, bv, bv, bv}; asm volatile("" : "+v"(bpat)); }
#define A8_SB() __builtin_amdgcn_sched_barrier(0)
#define A8_MFA(acc, A, B, sb) acc = __builtin_amdgcn_mfma_scale_f32_32x32x64_f8f6f4(A, B, acc, 0, 0, 0, SC_ONE, 0, sb)
#define A8_MFP(acc, A, B) acc = __builtin_amdgcn_mfma_scale_f32_32x32x64_f8f6f4(A, B, acc, 1, 0, 0, SC_ONE, 0, SC_ONE)
#define A8_KLOAD(t) do { kf[0] = ld32(A8_KS(t) + koff[0], A8_KS(t) + koff[1]); kf[1] = ld32(A8_KS(t) + 4096 + koff[0], A8_KS(t) + 4096 + koff[1]); \
    kf[2] = ld32(A8_KS(t) + koff[2], A8_KS(t) + koff[3]); kf[3] = ld32(A8_KS(t) + 4096 + koff[2], A8_KS(t) + 4096 + koff[3]); } while (0)
#define A8_VLOAD(t) do { _Pragma("unroll") for (int d0 = 0; d0 < 2; ++d0) vf[d0] = ld32(A8_VS(t) + d0 * 2048 + voff[0], A8_VS(t) + d0 * 2048 + voff[1]); } while (0)
#define A8_VLOAD2(t) do { _Pragma("unroll") for (int d0 = 2; d0 < 4; ++d0) vf[d0] = ld32(A8_VS(t) + d0 * 2048 + voff[0], A8_VS(t) + d0 * 2048 + voff[1]); } while (0)
#define A8_EXPS(P, lo, hi_) do { _Pragma("unroll") for (int r = (lo); r < (hi_); ++r) P[r] = __builtin_amdgcn_exp2f(P[r]); asm volatile("" : "+v"(P)); } while (0)
#define A8_PIN(x) asm volatile("" : "+v"(x))
#define A8_PK(w, P, i) pfN_[w] = pk4_bf8(P[i], P[(i) + 1], P[(i) + 2], P[(i) + 3])
#define A8_CVT4(H, i, P, r) do { H[i] = __builtin_bit_cast(unsigned, __builtin_amdgcn_cvt_pkrtz(P[r], P[(r) + 1])); H[(i) + 1] = __builtin_bit_cast(unsigned, __builtin_amdgcn_cvt_pkrtz(P[(r) + 2], P[(r) + 3])); \
    H[(i) + 2] = __builtin_bit_cast(unsigned, __builtin_amdgcn_cvt_pkrtz(P[(r) + 4], P[(r) + 5])); H[(i) + 3] = __builtin_bit_cast(unsigned, __builtin_amdgcn_cvt_pkrtz(P[(r) + 6], P[(r) + 7])); } while (0)
#define A8_EXH(H, a, b) asm volatile("v_exp_f16_sdwa %0, %0 dst_sel:WORD_0 dst_unused:UNUSED_PRESERVE src0_sel:WORD_0\n\tv_exp_f16_sdwa %1, %1 dst_sel:WORD_0 dst_unused:UNUSED_PRESERVE src0_sel:WORD_0\n\t" \
    "v_exp_f16_sdwa %0, %0 dst_sel:WORD_1 dst_unused:UNUSED_PRESERVE src0_sel:WORD_1\n\tv_exp_f16_sdwa %1, %1 dst_sel:WORD_1 dst_unused:UNUSED_PRESERVE src0_sel:WORD_1" : "+v"(H[a]), "+v"(H[b]))
#define A8_PKH(w, H, i) pfN_[w] = (int)__builtin_amdgcn_perm(H[(i) + 1], H[i], 0x07050301u)
#define A8_STEP(tk, tv_next, pN0, pN1, pO0, pO1, pfN, pfO) do { v8i& pfN_ = pfN; unsigned h0_[8], h1_[8]; \
    A8_SB(); A8_MFP(o[0], pfO, vf[0]); A8_PIN(o[0]); A8_SB(); \
    A8_VLOAD2((tk) - 2); A8_SB(); A8_CVT4(h0_, 0, pO0, 0); A8_EXH(h0_, 0, 1); A8_SB(); \
    A8_MFP(o[1], pfO, vf[1]); A8_PIN(o[1]); A8_SB(); \
    A8_CVT4(h0_, 4, pO0, 8); A8_EXH(h0_, 2, 3); A8_SB(); \
    A8_MFP(o[2], pfO, vf[2]); A8_PIN(o[2]); A8_SB(); \
    A8_KLOAD(tk); A8_SB(); A8_EXH(h0_, 4, 5); A8_SB(); \
    A8_MFP(o[3], pfO, vf[3]); A8_PIN(o[3]); A8_SB(); \
    A8_EXH(h0_, 6, 7); A8_PKH(0, h0_, 0); A8_PKH(1, h0_, 2); A8_PIN(pfN_); A8_SB(); \
    A8_ROWSUM(lsum, pfO, bpat); A8_PIN(lsum); A8_SB(); \
    A8_CVT4(h1_, 0, pO1, 0); A8_EXH(h1_, 0, 1); A8_PKH(2, h0_, 4); A8_PIN(pfN_); A8_SB(); \
    asm volatile("v_mfma_f32_32x32x64_f8f6f4 %0, %1, %2, -4.0" : "=&v"(pN0) : "v"(kf[0]), "v"(qf[0])); A8_SB(); \
    A8_STAGE((tk) + 2); A8_SB(); A8_CVT4(h1_, 4, pO1, 8); A8_EXH(h1_, 2, 3); A8_PKH(3, h0_, 6); A8_PIN(pfN_); A8_SB(); \
    asm volatile("v_mfma_f32_32x32x64_f8f6f4 %0, %1, %2, -4.0" : "=&v"(pN1) : "v"(kf[1]), "v"(qf[0])); A8_SB(); \
    A8_EXH(h1_, 4, 5); A8_PKH(4, h1_, 0); A8_PIN(pfN_); A8_SB(); \
    A8_MFA(pN0, kf[2], qf[1], SC_Q); A8_PIN(pN0); A8_SB(); \
    A8_EXH(h1_, 6, 7); A8_PKH(5, h1_, 2); A8_PIN(pfN_); A8_SB(); \
    A8_MFA(pN1, kf[3], qf[1], SC_Q); A8_PIN(pN1); A8_SB(); \
    A8_PKH(6, h1_, 4); A8_PKH(7, h1_, 6); A8_PIN(pfN_); \
    A8_VLOAD(tv_next); A8_SB(); } while (0)
  asm volatile("s_waitcnt vmcnt(0)" ::: "memory");
  A8_STAGE(0); A8_STAGE(1);
  A8_SYNC(0); A8_STAGE(2); qkt8(pA0, pA1, A8_KS(0), koff, qf);
  A8_SYNC(1); A8_STAGE(3); qkt8(pB0, pB1, A8_KS(1), koff, qf); softmax8p(pA0, pA1, pfA); A8_VLOAD(0);
  int j = 2;
  for (int jb = 0; jb < (NT - 2) / 8; ++jb) { j = 2 + 8 * jb;
#define A8_PAIR(i) A8_SYNC(j + (i)); A8_STEP(j + (i), j + (i) - 1, pA0, pA1, pB0, pB1, pfB, pfA); A8_SYNC(j + (i) + 1); A8_STEP(j + (i) + 1, j + (i), pB0, pB1, pA0, pA1, pfA, pfB)
    A8_PAIR(0); A8_PAIR(2); A8_PAIR(4); A8_PAIR(6);
  }
  for (j = 2 + 8 * ((NT - 2) / 8); j + 1 < NT; j += 2) { A8_PAIR(0); }
#undef A8_PAIR
  softmax8p(pB0, pB1, pfB); pv8(o, lsum, bpat, A8_VS(NT - 2), voff, pfA);
  pv8(o, lsum, bpat, A8_VS(NT - 1), voff, pfB);
#undef A8_STEP
#undef A8_CVT4
#undef A8_EXH
#undef A8_PKH
#undef A8_EXPS
#undef A8_MFP
#undef A8_PIN
#undef A8_PK
#undef A8_KLOAD
#undef A8_VLOAD
#undef A8_VLOAD2
#undef A8_MFA
#undef A8_SB
  if ((lane & 7) == 0) {
#pragma unroll
    for (int i = 0; i < 4; ++i) al_l[lrow0 + i] = __builtin_amdgcn_rcpf(lsum[i]) * 64.f; }
  asm volatile("s_waitcnt lgkmcnt(0)" ::: "memory");
  unsigned char* Ow = Ob + (size_t)(wid * 32) * LDO;
#pragma unroll
  for (int r = 0; r < 16; ++r) { const int orow = crow(r, hi); const float rl = al_l[orow];
#pragma unroll
    for (int d0 = 0; d0 < 4; ++d0) { const float v = o[d0][r] * rl; Ow[(size_t)orow * LDO + d0 * 32 + r32] = (unsigned char)(__builtin_amdgcn_cvt_pk_fp8_f32(v, v, 0, false) & 0xff); } }
  __builtin_amdgcn_s_setprio(0);
  A8_WAIT_V(0); A8_BAR();
#undef A8_STAGE
#undef A8_RESC
#undef A8_KS
#undef A8_VS
#undef A8_SYNC
}
}

#ifndef WGM_B
#define WGM_B 4
#endif
#ifndef WGM_E
#define WGM_E 4
#endif
#ifndef WGM_F
#define WGM_F 4
#endif
#ifndef WGM_H
#define WGM_H 4
#endif
#ifndef WGM_I
#define WGM_I 4
#endif
constexpr int NWAVES = 8;
constexpr int N_PHASES = 23;
constexpr size_t MiB = 1u << 20;
constexpr size_t WS_CTL = 0, CTL_ZERO_BYTES = 1 * MiB;
constexpr size_t WS_ROPE = 1 * MiB;
constexpr size_t WS_WIN = 2 * MiB;
constexpr size_t WS_WBR = WS_WIN + 44 * MiB;
constexpr size_t WS_WOUT = WS_WBR + 8 * MiB;
constexpr size_t WS_WFF1 = WS_WOUT + 8 * MiB;
constexpr size_t WS_WFF2 = WS_WFF1 + 32 * MiB;
constexpr size_t WS_HB = WS_WFF2 + 32 * MiB;
constexpr size_t WS_PROJ = WS_HB + 64 * MiB;
constexpr size_t WS_Q8 = WS_PROJ + 352 * MiB;
constexpr size_t WS_K8 = WS_Q8 + 24 * MiB;
constexpr size_t WS_V8 = WS_K8 + 8 * MiB;
constexpr size_t WS_OG = WS_V8 + 8 * MiB;
constexpr size_t WS_LSE = WS_OG + 96 * MiB;
constexpr size_t WS_Y = WS_LSE + 1 * MiB;
constexpr size_t WS_HB8 = WS_Y + 64 * MiB;
constexpr size_t WS_WIN8 = WS_HB8 + 32 * MiB;
constexpr size_t WS_WOUT8 = WS_WIN8 + 12 * MiB;
constexpr size_t WS_WBR8 = WS_WOUT8 + 4 * MiB;
constexpr size_t WS_END = WS_WBR8 + 4 * MiB;
constexpr int N_IN_BF16 = 0;
constexpr int CW_BAR = 4096;
constexpr size_t WS_SS2 = 512 * 1024;
constexpr size_t WS_SS = 256 * 1024;

constexpr int RING_OFF = 0, RING_BYTES = 131072;
constexpr int LDSCTL_OFF = RING_BYTES, MISC_OFF = LDSCTL_OFF + 320;
constexpr int LDS_BYTES = 147456;

#define GAS __attribute__((address_space(1)))
#define LAS __attribute__((address_space(3)))
typedef unsigned short bf16;
typedef unsigned v4u __attribute__((ext_vector_type(4)));
typedef float f32x4 __attribute__((ext_vector_type(4)));
typedef short bf16x8 __attribute__((ext_vector_type(8)));
typedef GAS unsigned gu32;
typedef GAS unsigned long long gu64;
#define RLX_AGENT __ATOMIC_RELAXED, __HIP_MEMORY_SCOPE_AGENT
#define LDS_WAIT() asm volatile("s_waitcnt lgkmcnt(0)" ::: "memory")
#define VM_WAIT() asm volatile("s_waitcnt vmcnt(0)" ::: "memory")
__device__ __forceinline__ unsigned long long rt() { return __builtin_amdgcn_s_memrealtime(); }
__device__ __forceinline__ unsigned f2bf(float f) { unsigned u = __builtin_bit_cast(unsigned, f); return (u + 0x7fffu + ((u >> 16) & 1u)) >> 16; }
__device__ __forceinline__ unsigned pk2(float lo, float hi) { return f2bf(lo) | (f2bf(hi) << 16); }

#define XB_TMO      128
#define XB_XCNT(j)  (256  + 64 * (j))
#define XB_XSUB(j)  (1280 + 64 * (j))
#define XB_XGEN(j)  (2304 + 64 * (j))
#define XB_TOP      3328
#define XB_TOPGEN   3392
#define XCD_BAR_WORDS 3456
#define XB_SPIN_CAP (1u << 18)

__device__ __forceinline__ unsigned xb_ld(unsigned* p)              { return __hip_atomic_load(p, __ATOMIC_RELAXED, __HIP_MEMORY_SCOPE_AGENT); }
__device__ __forceinline__ unsigned xb_add(unsigned* p, unsigned v) { return __hip_atomic_fetch_add(p, v, __ATOMIC_RELAXED, __HIP_MEMORY_SCOPE_AGENT); }
__device__ __forceinline__ unsigned xb_xcc_id() { return (unsigned)__builtin_amdgcn_s_getreg((3 << 11) | 20) & 0xFu; }
#define XB_SPIN(cond, bar) do { unsigned _sp = 0; while (cond) { __builtin_amdgcn_s_sleep(1); \
    if ((++_sp & 255u) == 0u) { if (xb_ld(&(bar)[XB_TMO])) break; if (_sp > XB_SPIN_CAP) { atomicAdd(&(bar)[XB_TMO], 1u); break; } } } } while (0)

struct XcdBarrier {
    unsigned* bar; unsigned x;
    volatile LAS unsigned* st;
};

__device__ __forceinline__ XcdBarrier xcd_barrier_post(unsigned* bar, volatile LAS unsigned* st) {
    XcdBarrier b; b.bar = bar; b.x = xb_xcc_id(); b.st = st;
    if (threadIdx.x == 0) (void)xb_add(&bar[XB_XCNT(b.x)], 1u);
    return b;
}
__device__ __forceinline__ void xcd_barrier_complete(unsigned* bar, unsigned x, unsigned& nloc, unsigned& nx) {
    const unsigned G = gridDim.x * gridDim.y * gridDim.z;
    unsigned sum, cnt, mine, sp = 0u;
    for (;;) {
        sum = 0u; cnt = 0u; mine = 0u;
#pragma unroll
        for (unsigned j = 0; j < 16; ++j) { const unsigned c = xb_ld(&bar[XB_XCNT(j)]); sum += c; cnt += (c > 0u) ? 1u : 0u; mine = (j == x) ? c : mine; }
        if (sum == G) break;
        __builtin_amdgcn_s_sleep(1);
        if ((++sp & 255u) == 0u) { if (xb_ld(&bar[XB_TMO])) break; if (sp > XB_SPIN_CAP) { atomicAdd(&bar[XB_TMO], 1u); break; } }
    }
    nloc = mine > 0u ? mine : 1u; nx = cnt > 0u ? cnt : 1u;
}

__device__ __forceinline__ void xcd_barrier(const XcdBarrier& b) {
    asm volatile("s_waitcnt vmcnt(0)" ::: "memory");
    __syncthreads();
    if (threadIdx.x == 0) {
        unsigned* bar = b.bar;
        __builtin_amdgcn_s_waitcnt(0);
        unsigned nloc = b.st[0], nx = b.st[1];
        if (nloc == 0u) { xcd_barrier_complete(bar, b.x, nloc, nx); b.st[0] = nloc; b.st[1] = nx; }
        const unsigned old = xb_add(&bar[XB_XSUB(b.x)], 1u);
        const unsigned gen = old / nloc;
        if (old + 1u == (gen + 1u) * nloc) {
            __builtin_amdgcn_fence(__ATOMIC_RELEASE, "agent");
            asm volatile("s_waitcnt vmcnt(0)" ::: "memory");
            const unsigned og = xb_add(&bar[XB_TOP], 1u);
            const unsigned tg = og / nx;
            if (og + 1u == (tg + 1u) * nx) xb_add(&bar[XB_TOPGEN], 1u);
            else XB_SPIN(xb_ld(&bar[XB_TOPGEN]) == tg, bar);
            __builtin_amdgcn_fence(__ATOMIC_ACQUIRE, "agent");
            xb_add(&bar[XB_XGEN(b.x)], 1u);
            asm volatile("s_waitcnt vmcnt(0)" ::: "memory");
        } else {
            XB_SPIN(xb_ld(&bar[XB_XGEN(b.x)]) == gen, bar);
            __builtin_amdgcn_fence(__ATOMIC_ACQUIRE, "agent");
            asm volatile("s_waitcnt vmcnt(0)" ::: "memory");
        }
    }
    __syncthreads();
}


__device__ __forceinline__ float wave_sum(float v) {
#pragma unroll
    for (int o = 1; o < 64; o <<= 1) v += __shfl_xor(v, o);
    return v;
}
template <bool GK>
__device__ __forceinline__ void p0_transpose_item(const float* W, int K, int N, bf16* WT, const float* gk, LAS float* scr, int item, int lane) {
    const int nblk = N / 32, kb = item / nblk, nb = item % nblk, k0 = 64 * kb, n0 = 32 * nb;
    float w[32];
#pragma unroll
    for (int i = 0; i < 32; ++i) w[i] = W[(size_t)(k0 + 2 * i + (lane >> 5)) * N + n0 + (lane & 31)];
    const int c = lane & 7;
    f32x4 g0 = {1.f, 1.f, 1.f, 1.f}, g1 = g0;
    if constexpr (GK) { g0 = *(const GAS f32x4*)(gk + k0 + 8 * c); g1 = *(const GAS f32x4*)(gk + k0 + 8 * c + 4); }
    __builtin_amdgcn_sched_barrier(0);
#pragma unroll
    for (int i = 0; i < 32; ++i) scr[(2 * i + (lane >> 5)) * 33 + (lane & 31)] = w[i];
    LDS_WAIT(); asm volatile("" ::: "memory");
#pragma unroll
    for (int j = 0; j < 4; ++j) { const int n = (lane >> 3) + 8 * j; const LAS float* s = scr + (8 * c) * 33 + n;
        v4u o; o.x = pk2(s[0 * 33] * g0.x, s[1 * 33] * g0.y); o.y = pk2(s[2 * 33] * g0.z, s[3 * 33] * g0.w); o.z = pk2(s[4 * 33] * g1.x, s[5 * 33] * g1.y); o.w = pk2(s[6 * 33] * g1.z, s[7 * 33] * g1.w);
        *(GAS v4u*)(WT + (size_t)(n0 + n) * K + k0 + 8 * c) = o; }
    LDS_WAIT(); asm volatile("" ::: "memory");
}
__device__ __forceinline__ unsigned pk4f8(float a, float b, float c, float d) { int x = 0; x = __builtin_amdgcn_cvt_pk_fp8_f32(a, b, x, false); x = __builtin_amdgcn_cvt_pk_fp8_f32(c, d, x, true); return (unsigned)x; }
__device__ __forceinline__ void p0_transpose_item_fp8(const float* W, int K, int N, unsigned char* WT8, int nbase, float wmul, LAS float* scr, int item, int lane, int gate0 = 1 << 30) {
    const int nblk = N / 32, kb = item / nblk, nb = item % nblk, k0 = 64 * kb, n0 = 32 * nb;
    int on0 = n0; if (n0 >= gate0) { const int gq = n0 - gate0, isb = gq >= 2048 ? 1 : 0, jq = gq - 2048 * isb; on0 = gate0 + (jq >> 7) * 256 + isb * 128 + (jq & 127); }
    float w[32];
#pragma unroll
    for (int i = 0; i < 32; ++i) w[i] = W[(size_t)(k0 + 2 * i + (lane >> 5)) * N + n0 + (lane & 31)];
    __builtin_amdgcn_sched_barrier(0);
#pragma unroll
    for (int i = 0; i < 32; ++i) scr[(2 * i + (lane >> 5)) * 33 + (lane & 31)] = w[i] * wmul;
    LDS_WAIT(); asm volatile("" ::: "memory");
    const int c = lane & 3;
#pragma unroll
    for (int j = 0; j < 2; ++j) { const int n = (lane >> 2) + 16 * j; const LAS float* s = scr + (16 * c) * 33 + n;
        v4u o; o.x = pk4f8(s[0 * 33], s[1 * 33], s[2 * 33], s[3 * 33]); o.y = pk4f8(s[4 * 33], s[5 * 33], s[6 * 33], s[7 * 33]);
        o.z = pk4f8(s[8 * 33], s[9 * 33], s[10 * 33], s[11 * 33]); o.w = pk4f8(s[12 * 33], s[13 * 33], s[14 * 33], s[15 * 33]);
        *(GAS v4u*)(WT8 + (size_t)(on0 - nbase + n) * K + k0 + 16 * c) = o; }
    LDS_WAIT(); asm volatile("" ::: "memory");
}
__device__ __forceinline__ void rms_row_to_bf16(const float* xrow, const float* g, bf16* orow, unsigned char* orow8, int lane) {
    const GAS f32x4* xr = (const GAS f32x4*)xrow + lane; const GAS f32x4* gr = (const GAS f32x4*)g + lane;
    f32x4 v[8]; float s = 0.f;
#pragma unroll
    for (int j = 0; j < 8; ++j) { v[j] = xr[64 * j]; s += (v[j].x * v[j].x + v[j].y * v[j].y) + (v[j].z * v[j].z + v[j].w * v[j].w); }
    const float r = 1.0f / sqrtf(wave_sum(s) * (1.f / DM) + RMS_EPS);
    GAS unsigned long long* o8 = (GAS unsigned long long*)orow + lane;
#pragma unroll
    for (int j = 0; j < 8; ++j) { const f32x4 gg = gr[64 * j]; const float y0 = v[j].x * r * gg.x, y1 = v[j].y * r * gg.y, y2 = v[j].z * r * gg.z, y3 = v[j].w * r * gg.w;
        o8[64 * j] = (unsigned long long)pk2(y0, y1) | ((unsigned long long)pk2(y2, y3) << 32); ((GAS unsigned*)orow8)[64 * j + lane] = pk4f8(y0, y1, y2, y3); }
}
__device__ __forceinline__ void rms_row2_to_bf16(const float* xa, const float* xb_, const float* g, bf16* oa, bf16* ob, unsigned char* oa8, unsigned char* ob8, int lane) {
    const GAS f32x4* xra = (const GAS f32x4*)xa + lane; const GAS f32x4* xrb = (const GAS f32x4*)xb_ + lane; const GAS f32x4* gr = (const GAS f32x4*)g + lane;
    f32x4 va[8], vb[8]; float sa = 0.f, sb = 0.f;
#pragma unroll
    for (int j = 0; j < 8; ++j) { va[j] = xra[64 * j]; vb[j] = xrb[64 * j]; }
#pragma unroll
    for (int j = 0; j < 8; ++j) { sa += (va[j].x * va[j].x + va[j].y * va[j].y) + (va[j].z * va[j].z + va[j].w * va[j].w); sb += (vb[j].x * vb[j].x + vb[j].y * vb[j].y) + (vb[j].z * vb[j].z + vb[j].w * vb[j].w); }
    const float ra = 1.0f / sqrtf(wave_sum(sa) * (1.f / DM) + RMS_EPS), rb = 1.0f / sqrtf(wave_sum(sb) * (1.f / DM) + RMS_EPS);
    (void)oa; (void)ob;
#pragma unroll
    for (int j = 0; j < 8; ++j) { const f32x4 gg = gr[64 * j];
        { const float y0 = va[j].x * ra * gg.x, y1 = va[j].y * ra * gg.y, y2 = va[j].z * ra * gg.z, y3 = va[j].w * ra * gg.w;
          ((GAS unsigned*)oa8)[64 * j + lane] = pk4f8(y0, y1, y2, y3); }
        { const float y0 = vb[j].x * rb * gg.x, y1 = vb[j].y * rb * gg.y, y2 = vb[j].z * rb * gg.z, y3 = vb[j].w * rb * gg.w;
          ((GAS unsigned*)ob8)[64 * j + lane] = pk4f8(y0, y1, y2, y3); } }
}
__device__ __forceinline__ void rms_row_f32_inplace(float* xrow, const float* g, int lane) {
    GAS f32x4* xr = (GAS f32x4*)xrow + lane; const GAS f32x4* gr = (const GAS f32x4*)g + lane;
    f32x4 v[8]; float s = 0.f;
#pragma unroll
    for (int j = 0; j < 8; ++j) { v[j] = xr[64 * j]; s += (v[j].x * v[j].x + v[j].y * v[j].y) + (v[j].z * v[j].z + v[j].w * v[j].w); }
    const float r = 1.0f / sqrtf(wave_sum(s) * (1.f / DM) + RMS_EPS);
#pragma unroll
    for (int j = 0; j < 8; ++j) { const f32x4 gg = gr[64 * j]; xr[64 * j] = (f32x4){v[j].x * r * gg.x, v[j].y * r * gg.y, v[j].z * r * gg.z, v[j].w * r * gg.w}; }
}
__device__ __forceinline__ void fin_row(const bf16* xrow, float ssq, const float* g, float* orow, int lane) {
    const float r = 1.0f / sqrtf(ssq * (1.f / DM) + RMS_EPS);
    v4u b[4];
#pragma unroll
    for (int j = 0; j < 4; ++j) b[j] = *(const GAS v4u*)(xrow + 512 * j + 8 * lane);
#pragma unroll
    for (int j = 0; j < 4; ++j) { const GAS f32x4* gp = (const GAS f32x4*)(g + 512 * j + 8 * lane); const f32x4 g0 = gp[0], g1 = gp[1];
        const f32x4 y0 = {pg8::bf_lo(b[j][0]) * r * g0.x, pg8::bf_hi(b[j][0]) * r * g0.y, pg8::bf_lo(b[j][1]) * r * g0.z, pg8::bf_hi(b[j][1]) * r * g0.w};
        const f32x4 y1 = {pg8::bf_lo(b[j][2]) * r * g1.x, pg8::bf_hi(b[j][2]) * r * g1.y, pg8::bf_lo(b[j][3]) * r * g1.z, pg8::bf_hi(b[j][3]) * r * g1.w};
        GAS f32x4* op = (GAS f32x4*)(orow + 512 * j + 8 * lane); op[0] = y0; op[1] = y1; }
}
__device__ __forceinline__ void fin_row4(const bf16* x, const float* ssq, const float* g, float* o, int m, int stride, int lane) {
    v4u b[4][4]; float r[4];
#pragma unroll
    for (int q = 0; q < 4; ++q)
#pragma unroll
        for (int j = 0; j < 4; ++j) b[q][j] = *(const GAS v4u*)(x + (size_t)(m + q * stride) * DM + 512 * j + 8 * lane);
#pragma unroll
    for (int q = 0; q < 4; ++q) r[q] = 1.0f / sqrtf(ssq[m + q * stride] * (1.f / DM) + RMS_EPS);
#pragma unroll
    for (int j = 0; j < 4; ++j) { const GAS f32x4* gp = (const GAS f32x4*)(g + 512 * j + 8 * lane); const f32x4 g0 = gp[0], g1 = gp[1];
#pragma unroll
        for (int q = 0; q < 4; ++q) { const float rq = r[q];
            const f32x4 y0 = {pg8::bf_lo(b[q][j][0]) * rq * g0.x, pg8::bf_hi(b[q][j][0]) * rq * g0.y, pg8::bf_lo(b[q][j][1]) * rq * g0.z, pg8::bf_hi(b[q][j][1]) * rq * g0.w};
            const f32x4 y1 = {pg8::bf_lo(b[q][j][2]) * rq * g1.x, pg8::bf_hi(b[q][j][2]) * rq * g1.y, pg8::bf_lo(b[q][j][3]) * rq * g1.z, pg8::bf_hi(b[q][j][3]) * rq * g1.w};
            GAS f32x4* op = (GAS f32x4*)(o + (size_t)(m + q * stride) * DM + 512 * j + 8 * lane); op[0] = y0; op[1] = y1; } }
}
__device__ __forceinline__ void sincos_d(double a, double& s, double& c) {
    const double TWO_PI = 6.283185307179586476925286766559;
    const double k = rint(a / TWO_PI); const double x = a - k * TWO_PI, x2 = x * x;
    double ts = 1.0, tc = 1.0, ss = 1.0, cc = 1.0;
#pragma unroll 1
    for (int n = 1; n <= 16; ++n) { tc = -tc * x2 / (double)((2 * n - 1) * (2 * n)); ts = -ts * x2 / (double)((2 * n) * (2 * n + 1)); cc += tc; ss += ts; }
    s = ss * x; c = cc;
}

struct Args { const float* in[12]; float* out; unsigned char* ws; int ph_lo, ph_hi, li, pad; };

__global__ void __launch_bounds__(NWAVES * 64, 2) enc_fwd(Args args) {
    extern __shared__ __attribute__((aligned(16))) unsigned char lds[];
    LAS unsigned char* ldsl = (LAS unsigned char*)lds;
    volatile LAS unsigned* MISC = (volatile LAS unsigned*)(ldsl + MISC_OFF);
    const int tid = threadIdx.x;
    const int G = gridDim.x, bx = blockIdx.x;
    const int vcu = (G % 8 == 0) ? (bx % 8) * (G / 8) + bx / 8 : bx;
    unsigned char* ws = args.ws;
    gu32* ctl = (gu32*)(ws + WS_CTL);
    for (int u = tid; u < (LDS_BYTES - LDSCTL_OFF) / 4; u += NWAVES * 64) ((LAS unsigned*)(ldsl + LDSCTL_OFF))[u] = 0u;
    __syncthreads();
    XcdBarrier bar; bar.bar = (unsigned*)(ctl + CW_BAR); bar.x = 0; bar.st = nullptr;
    const int lo = args.ph_lo, hi = args.ph_hi;
    if (hi - lo > 1) bar = xcd_barrier_post((unsigned*)(ctl + CW_BAR) + args.li * XCD_BAR_WORDS, MISC + 8);
#define IN(k) (lo <= (k) && (k) < hi)
#define SEAM(k) do { if (IN((k) + 1)) xcd_barrier(bar); } while (0)

#define PH_ARGS() const __attribute__((address_space(4))) Args* A_ = (const __attribute__((address_space(4))) Args*)__builtin_amdgcn_kernarg_segment_ptr(); asm volatile("" : "+s"(A_)); unsigned char* const ws_ = A_->ws; (void)ws_
#define x_prompt (A_->in[0])
#define x_sample (A_->in[1])
#define g_mix (A_->in[2])
#define w_in (A_->in[3])
#define g_q (A_->in[4])
#define g_k (A_->in[5])
#define w_branch (A_->in[6])
#define w_out (A_->in[7])
#define g_mlp (A_->in[8])
#define w_ff1 (A_->in[9])
#define w_ff2 (A_->in[10])
#define g_final (A_->in[11])
#define Win_t ((bf16*)(ws_ + WS_WIN))
#define Wbr_t ((bf16*)(ws_ + WS_WBR))
#define Wout_t ((bf16*)(ws_ + WS_WOUT))
#define Wff1_t ((bf16*)(ws_ + WS_WFF1))
#define Wff2_t ((bf16*)(ws_ + WS_WFF2))
#define HB ((bf16*)(ws_ + WS_HB))
#define PROJ ((bf16*)(ws_ + WS_PROJ))
#define UB ((bf16*)(ws_ + WS_PROJ))
#define Q8 (ws_ + WS_Q8)
#define K8 (ws_ + WS_K8)
#define V8 (ws_ + WS_V8)
#define OG ((bf16*)(ws_ + WS_OG))
#define MG ((bf16*)(ws_ + WS_OG))
#define LSE ((float*)(ws_ + WS_LSE))
#define YB ((bf16*)(ws_ + WS_Y))
#define H2B ((bf16*)(ws_ + WS_Y))
#define ROPE ((float2*)(ws_ + WS_ROPE))
#define HB8 (ws_ + WS_HB8)
#define X2B ((bf16*)(ws_ + WS_HB))
#define Win8_t (ws_ + WS_WIN)
#define Wout8_t (ws_ + WS_WOUT8)
#define Wbr8_t (ws_ + WS_WBR8)
#define XS_ ((s == 0) ? x_prompt : x_sample + (size_t)(s - 1) * SEQ * DM)
#define OUTS_ (A_->out + (size_t)s * SEQ * DM)
    const int NGW = G * NWAVES, NGT = NGW * 64;
#define LANE_IDS() const int tid_ = pg8::otid(), lane = tid_ & 63, wave = __builtin_amdgcn_readfirstlane(tid_ >> 6), gw = vcu * NWAVES + wave, gt = gw * 64 + lane; (void)gt; (void)gw; (void)lane

    if (IN(0)) {
        PH_ARGS(); LANE_IDS();
        LAS float* scr = (LAS float*)(ldsl + RING_OFF + wave * 16384);
        constexpr int I_IN = (DM / 64) * (INW / 32), I_SQ = (DM / 64) * (DM / 32), I_F1 = (DM / 64) * (DFF / 32), I_F2 = (DFF / 64) * (DM / 32);
        constexpr int NITEMS = I_IN + 2 * I_SQ + I_F1 + I_F2;
        for (int it = gw; it < NITEMS; it += NGW) {
            int r = it;
            if (r < I_IN) { if ((r % (INW / 32)) * 32 < N_IN_BF16) p0_transpose_item<false>(w_in, DM, INW, Win_t, nullptr, scr, r, lane);
                            else p0_transpose_item_fp8(w_in, DM, INW, Win8_t, N_IN_BF16, 64.0f, scr, r, lane, C_GA); continue; } r -= I_IN;
            if (r < I_SQ) { p0_transpose_item_fp8(w_branch, DM, DM, Wbr8_t, 0, 32.0f, scr, r, lane); continue; } r -= I_SQ;
            if (r < I_SQ) { p0_transpose_item_fp8(w_out, DM, DM, Wout8_t, 0, 64.0f, scr, r, lane); continue; } r -= I_SQ;
            if (r < I_F1) { p0_transpose_item<true>(w_ff1, DM, DFF, Wff1_t, g_mlp, scr, r, lane); continue; } r -= I_F1;
            p0_transpose_item<false>(w_ff2, DFF, DM, Wff2_t, nullptr, scr, r, lane);
        }
        for (int i = gt; i < 256 * 32; i += NGT) {
            const int pos = i >> 5, f = i & 31;
            double iv = 1.0; for (int q = 0; q < f; ++q) iv *= 0.7498942093324559;
            const float invf = (float)iv;
            const float ang = (float)pos * invf; double s, c; sincos_d((double)ang, s, c);
            ROPE[i] = make_float2((float)c, (float)s);
        }
        for (int m = gw; m < SEQ; m += 2 * NGW) { const int m2 = m + NGW; rms_row2_to_bf16(x_prompt + (size_t)m * DM, x_prompt + (size_t)m2 * DM, g_mix, HB + (size_t)m * DM, HB + (size_t)m2 * DM, HB8 + (size_t)m * DM, HB8 + (size_t)m2 * DM, lane); }
        SEAM(0);
    }

    for (int s = 0; s < NSEQ; ++s) {
        const int pb = 1 + 7 * s;

        if (IN(pb + 0)) {
            PH_ARGS();
            if (s > 0) { LANE_IDS(); const float* ss2 = (const float*)(ws_ + WS_SS2) + (size_t)(s - 1) * SEQ; float* op = A_->out + (size_t)(s - 1) * SEQ * DM;
                { int m = gw; for (; m + 3 * NGW < SEQ; m += 4 * NGW) fin_row4(X2B, ss2, g_final, op, m, NGW, lane);
                  for (; m < SEQ; m += NGW) fin_row(X2B + (size_t)m * DM, ss2[m], g_final, op + (size_t)m * DM, lane); }
                __syncthreads(); }
            { pg8::Gemm g{HB, Win_t, SEQ, N_IN_BF16, DM}; pg8::StaticOrder S; S.init(SEQ, N_IN_BF16, G, bx);
              pg8::EpiBf16<0> E{PROJ, INW, 1.0f, nullptr};
              pg8::gemm_phase<pg8::EpiBf16<0>, pg8::StaticOrder, true, true>(ldsl + RING_OFF, g, S, E); }
            __syncthreads();
            { pg8::Gemm g{(const bf16*)HB8, (const bf16*)Win8_t, SEQ, INW - N_IN_BF16, DM / 2}; pg8::StaticOrder S; S.init(SEQ, INW - N_IN_BF16, G, bx, WGM_B);
              pg8::EpiBf16<0, false, (C_GA - N_IN_BF16) / 256> E{PROJ + N_IN_BF16, INW, 1.0f / 64.0f, nullptr};
              pg8::gemm_phase<pg8::EpiBf16<0, false, (C_GA - N_IN_BF16) / 256>, pg8::StaticOrder, true, true, true>(ldsl + RING_OFF, g, S, E); }
            SEAM(pb + 0);
        }
        if (IN(pb + 1)) {
            PH_ARGS();
            {   LANE_IDS();
                const int j = gt & 7, a = j >> 2, jj = j & 3;
#pragma unroll 2
                for (int item = gt >> 3; item < SEQ * 16; item += NGT >> 3) {
                    const int t = item >> 4, hh = item & 15;
                    const bf16* src; unsigned char* dst1; unsigned char* dst2; const float* gg; float osc;
                    const int o1 = 64 * a + 8 * jj, o2 = o1 + 32;
                    if (hh < 12) { src = PROJ + (size_t)t * INW + C_BQ + hh * 128; dst1 = Q8 + (size_t)t * 1536 + hh * 128 + o1; dst2 = dst1 + 32; gg = g_q; osc = att::SCALE * LOG2E * 8.0f; }
                    else { src = PROJ + (size_t)t * INW + C_BK + (hh - 12) * 128; gg = g_k; osc = 0.125f;
                        const int ki = t & 63, sw = (ki >> 1) & 7; unsigned char* tb = K8 + ((size_t)(hh - 12) * 256 + (t >> 6)) * 8192 + ki * 128;
                        dst1 = tb + ((((o1 >> 4) ^ sw)) << 4) + (o1 & 15); dst2 = tb + ((((o2 >> 4) ^ sw)) << 4) + (o2 & 15); }
                    const v4u w1 = *(const GAS v4u*)(src + o1), w2 = *(const GAS v4u*)(src + o2);
                    float x1[8], x2[8]; float ss = 0.f;
#pragma unroll
                    for (int e = 0; e < 4; ++e) { x1[2 * e] = pg8::bf_lo(w1[e]); x1[2 * e + 1] = pg8::bf_hi(w1[e]); x2[2 * e] = pg8::bf_lo(w2[e]); x2[2 * e + 1] = pg8::bf_hi(w2[e]); }
#pragma unroll
                    for (int e = 0; e < 8; ++e) ss += x1[e] * x1[e] + x2[e] * x2[e];
                    ss += __shfl_xor(ss, 1); ss += __shfl_xor(ss, 2); ss += __shfl_xor(ss, 4);
                    const float rinv = osc / sqrtf(ss * (1.f / 128.f) + RMS_EPS);
                    const int pos = (a == 0) ? (t >> 6) : (t & 63);
                    const float2* rt_ = ROPE + pos * 32 + 8 * jj;
                    float y1[8], y2[8];
#pragma unroll
                    for (int e = 0; e < 8; ++e) { const float2 cs = rt_[e]; const float u1 = x1[e] * rinv * gg[o1 + e], u2 = x2[e] * rinv * gg[o2 + e];
                        y1[e] = u1 * cs.x - u2 * cs.y; y2[e] = u2 * cs.x + u1 * cs.y; }
                    int q1a = 0, q1b = 0, q2a = 0, q2b = 0;
                    q1a = __builtin_amdgcn_cvt_pk_fp8_f32(y1[0], y1[1], q1a, false); q1a = __builtin_amdgcn_cvt_pk_fp8_f32(y1[2], y1[3], q1a, true);
                    q1b = __builtin_amdgcn_cvt_pk_fp8_f32(y1[4], y1[5], q1b, false); q1b = __builtin_amdgcn_cvt_pk_fp8_f32(y1[6], y1[7], q1b, true);
                    q2a = __builtin_amdgcn_cvt_pk_fp8_f32(y2[0], y2[1], q2a, false); q2a = __builtin_amdgcn_cvt_pk_fp8_f32(y2[2], y2[3], q2a, true);
                    q2b = __builtin_amdgcn_cvt_pk_fp8_f32(y2[4], y2[5], q2b, false); q2b = __builtin_amdgcn_cvt_pk_fp8_f32(y2[6], y2[7], q2b, true);
                    *(GAS unsigned long long*)dst1 = (unsigned long long)(unsigned)q1a | ((unsigned long long)(unsigned)q1b << 32);
                    *(GAS unsigned long long*)dst2 = (unsigned long long)(unsigned)q2a | ((unsigned long long)(unsigned)q2b << 32);
                }
                constexpr int NVI = 256 * 4 * 4 * 128;
                if (NVI % (4 * NGT) == 0) {
                  for (int base = gt; base < NVI; base += 4 * NGT) {
                    unsigned f[4][16];
#pragma unroll
                    for (int b = 0; b < 4; ++b) { const int item = base + b * NGT;
                        const int d = item & 127, q = (item >> 7) & 3, kvh = (item >> 9) & 3, tile = item >> 11, h = q >> 1, half = q & 1;
                        const bf16* vp = PROJ + (size_t)(tile * 64 + 32 * half + 4 * h) * INW + C_BV + kvh * 128 + d;
#pragma unroll
                        for (int pp = 0; pp < 16; ++pp) f[b][pp] = vp[(size_t)((pp & 3) + 8 * (pp >> 2)) * INW]; }
                    __builtin_amdgcn_sched_barrier(0);
#pragma unroll
                    for (int b = 0; b < 4; ++b) { const int item = base + b * NGT;
                        const int d = item & 127, q = (item >> 7) & 3, kvh = (item >> 9) & 3, tile = item >> 11;
                        v4u w;
#pragma unroll
                        for (int e = 0; e < 4; ++e) { int x = 0; x = __builtin_amdgcn_cvt_pk_fp8_f32(__uint_as_float(f[b][4 * e] << 16), __uint_as_float(f[b][4 * e + 1] << 16), x, false);
                            x = __builtin_amdgcn_cvt_pk_fp8_f32(__uint_as_float(f[b][4 * e + 2] << 16), __uint_as_float(f[b][4 * e + 3] << 16), x, true); w[e] = (unsigned)x; }
                        *(GAS v4u*)(V8 + ((size_t)kvh * 256 + tile) * 8192 + d * 64 + ((q ^ ((d >> 2) & 3)) << 4)) = w; } }
                } else {
                  for (int item = gt; item < NVI; item += NGT) {
                    const int d = item & 127, q = (item >> 7) & 3, kvh = (item >> 9) & 3, tile = item >> 11, h = q >> 1, half = q & 1;
                    const bf16* vp = PROJ + (size_t)(tile * 64 + 32 * half + 4 * h) * INW + C_BV + kvh * 128 + d;
                    float f[16];
#pragma unroll
                    for (int pp = 0; pp < 16; ++pp) f[pp] = __uint_as_float((unsigned)vp[(size_t)((pp & 3) + 8 * (pp >> 2)) * INW] << 16);
                    v4u w;
#pragma unroll
                    for (int e = 0; e < 4; ++e) { int x = 0; x = __builtin_amdgcn_cvt_pk_fp8_f32(f[4 * e], f[4 * e + 1], x, false); x = __builtin_amdgcn_cvt_pk_fp8_f32(f[4 * e + 2], f[4 * e + 3], x, true); w[e] = (unsigned)x; }
                    *(GAS v4u*)(V8 + ((size_t)kvh * 256 + tile) * 8192 + d * 64 + ((q ^ ((d >> 2) & 3)) << 4)) = w; }
                }
            }
            if (s + 1 < NSEQ) { LANE_IDS(); const float* xn = x_sample + (size_t)s * SEQ * DM;
                for (int m = gw; m < SEQ; m += 2 * NGW) { const int m2 = m + NGW; rms_row2_to_bf16(xn + (size_t)m * DM, xn + (size_t)m2 * DM, g_mix, HB + (size_t)m * DM, HB + (size_t)m2 * DM, HB8 + (size_t)m * DM, HB8 + (size_t)m2 * DM, lane); } }
            __syncthreads();
            for (int u = vcu; u < 768; u += G) {
                const int g = u >> 8, h = (u >> 6) & 3, rb = u & 63;
                const int d = (g == 0) ? 1 : (g == 1 ? 4 : 16), nblk = (SEQ / d) / 256;
                const int res = rb / nblk, blk = rb % nblk;
                att::dil_unit((const att::bf16*)PROJ, OG, LSE, g, h, res, blk * 256, (char*)lds + RING_OFF);
            }
            SEAM(pb + 1);
        }
        if (IN(pb + 2)) {
            PH_ARGS();
            { LANE_IDS();
            for (int item = gt; item < SEQ * 64; item += NGT) {
                const int t = item >> 6, h = (item >> 4) & 3, c = item & 15;
                const float l0 = LSE[(size_t)t * 12 + h], l1 = LSE[(size_t)t * 12 + 4 + h], l2 = LSE[(size_t)t * 12 + 8 + h];
                const float mx = fmaxf(l0, fmaxf(l1, l2)); float e0 = __expf(l0 - mx), e1 = __expf(l1 - mx), e2 = __expf(l2 - mx);
                const float rs = 1.0f / (e0 + e1 + e2); e0 *= rs; e1 *= rs; e2 *= rs;
                const bf16* o0 = OG + (size_t)t * 1536 + h * 128 + 8 * c;
                const v4u ua = *(const GAS v4u*)(o0), ub = *(const GAS v4u*)(o0 + 512), uc = *(const GAS v4u*)(o0 + 1024);
                const f32x4 a0 = {pg8::bf_lo(ua[0]), pg8::bf_hi(ua[0]), pg8::bf_lo(ua[1]), pg8::bf_hi(ua[1])}, a1 = {pg8::bf_lo(ua[2]), pg8::bf_hi(ua[2]), pg8::bf_lo(ua[3]), pg8::bf_hi(ua[3])};
                const f32x4 b0 = {pg8::bf_lo(ub[0]), pg8::bf_hi(ub[0]), pg8::bf_lo(ub[1]), pg8::bf_hi(ub[1])}, b1 = {pg8::bf_lo(ub[2]), pg8::bf_hi(ub[2]), pg8::bf_lo(ub[3]), pg8::bf_hi(ub[3])};
                const f32x4 c0 = {pg8::bf_lo(uc[0]), pg8::bf_hi(uc[0]), pg8::bf_lo(uc[1]), pg8::bf_hi(uc[1])}, c1 = {pg8::bf_lo(uc[2]), pg8::bf_hi(uc[2]), pg8::bf_lo(uc[3]), pg8::bf_hi(uc[3])};
                const f32x4 r0 = a0 * e0 + b0 * e1 + c0 * e2, r1 = a1 * e0 + b1 * e1 + c1 * e2;
                const unsigned w0 = pk4f8(r0.x * 4.f, r0.y * 4.f, r0.z * 4.f, r0.w * 4.f), w1 = pk4f8(r1.x * 4.f, r1.y * 4.f, r1.z * 4.f, r1.w * 4.f);
                *(GAS unsigned long long*)((unsigned char*)YB + (size_t)t * DM + h * 128 + 8 * c) = (unsigned long long)w0 | ((unsigned long long)w1 << 32);
            } }
            for (int u = vcu; u < 768; u += G) {
                const int hq = u >> 6, qb = u & 63, kvh = hq / 3;
                __syncthreads();
                att8::attn8_body<1536, DM>(Q8 + (size_t)qb * 256 * 1536 + hq * 128, K8 + (size_t)kvh * 256 * 8192, V8 + (size_t)kvh * 256 * 8192,
                                           (unsigned char*)YB + (size_t)qb * 256 * DM + 512 + hq * 128, SEQ / 64, ldsl + RING_OFF);
            }
            SEAM(pb + 2);
        }
        if (IN(pb + 3)) {
            PH_ARGS();
            __syncthreads();
            pg8::Gemm g{YB, (const bf16*)Wbr8_t, SEQ, DM, DM / 2}; pg8::StaticOrder S; S.init(SEQ, DM, G, bx, WGM_E);
            pg8::EpiGate E{MG, DM, PROJ, INW, C_GA, (unsigned)((size_t)SEQ * INW * 2)};
            pg8::gemm_phase<pg8::EpiGate, pg8::StaticOrder, true, true, true>(ldsl + RING_OFF, g, S, E);
            SEAM(pb + 3);
        }
        if (IN(pb + 4)) {
            PH_ARGS();
            pg8::Gemm g{MG, (const bf16*)Wout8_t, SEQ, DM, DM / 2}; pg8::StaticOrder S; S.init(SEQ, DM, G, bx, WGM_F);
            pg8::EpiResBf16Stats E{XS_, H2B, DM, (float*)(ws_ + WS_SS) + (size_t)s * SEQ, 1.0f / 512.0f};
            pg8::gemm_phase<pg8::EpiResBf16Stats, pg8::StaticOrder, true, true, true>(ldsl + RING_OFF, g, S, E);
            SEAM(pb + 4);
        }
        if (IN(pb + 5)) {
            PH_ARGS();
            pg8::Gemm g{H2B, Wff1_t, SEQ, DFF, DM}; pg8::StaticOrder S; S.init(SEQ, DFF, G, bx, WGM_H);
            pg8::EpiBf16<2, true> E{UB, DFF, 1.0f, (const float*)(ws_ + WS_SS) + (size_t)s * SEQ};
            pg8::gemm_phase<pg8::EpiBf16<2, true>, pg8::StaticOrder, true, true>(ldsl + RING_OFF, g, S, E);
            SEAM(pb + 5);
        }
        if (IN(pb + 6)) {
            PH_ARGS();
            pg8::Gemm g{UB, Wff2_t, SEQ, DM, DFF}; pg8::StaticOrder S; S.init(SEQ, DM, G, bx, WGM_I);
            pg8::EpiResBf16FromBf16Stats E{H2B, X2B, DM, (float*)(ws_ + WS_SS2) + (size_t)s * SEQ};
            pg8::gemm_phase<pg8::EpiResBf16FromBf16Stats, pg8::StaticOrder, true, true>(ldsl + RING_OFF, g, S, E);
            SEAM(pb + 6);
        }
    }
    if (IN(22)) {
        PH_ARGS(); LANE_IDS();
        { const float* ss2 = (const float*)(ws_ + WS_SS2) + (size_t)(NSEQ - 1) * SEQ; float* op = A_->out + (size_t)(NSEQ - 1) * SEQ * DM;
          { int m = gw; for (; m + 3 * NGW < SEQ; m += 4 * NGW) fin_row4(X2B, ss2, g_final, op, m, NGW, lane);
            for (; m < SEQ; m += NGW) fin_row(X2B + (size_t)m * DM, ss2[m], g_final, op + (size_t)m * DM, lane); } }
    }
#undef IN
#undef SEAM
}

extern "C" void kernel_launch(void* const* d_in, const int* in_sizes, int n_in, void* d_out, int out_size, void* d_ws, size_t ws_size, hipStream_t stream) {
    static int grid = 0;
    if (grid == 0) {
        if (n_in != 12 || ws_size < WS_END) { fprintf(stderr, "kernel_launch: expected 12 inputs and >= %zu bytes of workspace; got n_in %d ws %zu\n", (size_t)WS_END, n_in, ws_size); grid = -1; return; }
        int dev = 0, cus = 0, per_cu = 0;
        if (hipGetDevice(&dev) != hipSuccess || hipDeviceGetAttribute(&cus, hipDeviceAttributeMultiprocessorCount, dev) != hipSuccess) { grid = -1; return; }
        if (hipFuncSetAttribute((const void*)enc_fwd, hipFuncAttributeMaxDynamicSharedMemorySize, LDS_BYTES) != hipSuccess) { fprintf(stderr, "kernel_launch: hipFuncSetAttribute failed\n"); grid = -1; return; }
        if (hipOccupancyMaxActiveBlocksPerMultiprocessor(&per_cu, (const void*)enc_fwd, NWAVES * 64, LDS_BYTES) != hipSuccess || per_cu < 1)
            fprintf(stderr, "kernel_launch: occupancy query reports %d workgroups per CU\n", per_cu);
        (void)hipGetLastError();
        grid = cus;
    }
    if (grid < 0) return;
    if (hipMemsetAsync((char*)d_ws + WS_CTL, 0, CTL_ZERO_BYTES, stream) != hipSuccess) return;
    Args a{};
    for (int i = 0; i < 12; ++i) a.in[i] = (const float*)d_in[i];
    a.out = (float*)d_out; a.ws = (unsigned char*)d_ws;
#if MK_N_LAUNCHES == 1
    a.ph_lo = 0; a.ph_hi = N_PHASES; a.li = 0;
    hipLaunchKernelGGL(enc_fwd, dim3(grid), dim3(NWAVES * 64), LDS_BYTES, stream, a);
#else
    for (int p = 0; p < N_PHASES; ++p) { a.ph_lo = p; a.ph_hi = p + 1; a.li = 0;
        hipLaunchKernelGGL(enc_fwd, dim3(grid), dim3(NWAVES * 64), LDS_BYTES, stream, a); }
#endif
    const hipError_t le = hipPeekAtLastError();
    if (le != hipSuccess) fprintf(stderr, "kernel_launch: launch failed: %s\n", hipGetErrorName(le));
}
```
